# Optimizing an MI355X kernel written in HIP

```python
import math
import jax, jax.numpy as jnp
from jax import lax
import numpy as np

D_MODEL = 1024
BATCH = 1
SEQ = 16384
DEPTH = 2
DEC_BATCH = 32
DEC_SEQ = 64
PAST_LEN = 1024

CHUNK = 64
Q_BLOCK = 128
N_MEM = 256
EPS = 1e-6
ROPE_THETA = 10000.0
NEG = -1e30
F32 = jnp.float32

MLA_HEADS = 8
MLA_NOPE = 128
MLA_ROPE = 64
MLA_V = 128
MLA_Q_RANK = 384
MLA_KV_RANK = 256
MLA_IN = MLA_Q_RANK + MLA_KV_RANK + MLA_ROPE
MLA_OUT = MLA_HEADS * MLA_V

HG_HEADS = 8
HG_DIM = 128
HG_WIDTH = HG_HEADS * HG_DIM

X_HEADS = 4
X_DIM = 128
X_WIDTH = X_HEADS * X_DIM

D_FF = 4 * D_MODEL

N_MLA_LAYERS = (DEPTH + 1) // 2
N_HGRN_LAYERS = DEPTH // 2
MIX_OUT = MLA_OUT + X_WIDTH

kernel_name = 'hybrid_mla_hgrn2_stream_step'


def rmsnorm(x, g):
    xf = x.astype(F32)
    y = xf * lax.rsqrt(jnp.mean(xf * xf, axis=-1, keepdims=True) + EPS)
    return (y * g.astype(F32)).astype(x.dtype)


def rope(x, pos):
    half = x.shape[-1] // 2
    inv = jnp.power(ROPE_THETA, -jnp.arange(half, dtype=F32) / half)
    ang = pos.astype(F32)[:, None] * inv[None, :]
    ang = ang.reshape((1, ang.shape[0]) + (1,) * (x.ndim - 3) + (half,))
    cos, sin = jnp.cos(ang), jnp.sin(ang)
    xf = x.astype(F32)
    x1, x2 = xf[..., :half], xf[..., half:]
    return jnp.concatenate([x1 * cos - x2 * sin, x2 * cos + x1 * sin], axis=-1).astype(x.dtype)


def mla_attention(q_lat, q_rope, lat_all, krope_all, q_pos):
    B, T, H, C = q_lat.shape
    L = lat_all.shape[1]
    k_chunk = jnp.arange(L) // CHUNK
    scale = (MLA_NOPE + MLA_ROPE) ** -0.5

    def block(args):
        ql, qr, qp = args
        s = (jnp.einsum('bqhc,bkc->bhqk', ql, lat_all)
             + jnp.einsum('bqhr,bkr->bhqk', qr, krope_all)).astype(F32) * scale
        mask = k_chunk[None, :] <= (qp // CHUNK)[:, None]
        p = jax.nn.softmax(jnp.where(mask, s, NEG), axis=-1).astype(lat_all.dtype)
        return jnp.einsum('bhqk,bkc->bqhc', p, lat_all)

    qb = Q_BLOCK if T % Q_BLOCK == 0 else T
    nb = T // qb
    if nb == 1:
        return block((q_lat, q_rope, q_pos))
    split = lambda a: jnp.moveaxis(a.reshape((B, nb, qb) + a.shape[2:]), 1, 0)
    out = lax.map(block, (split(q_lat), split(q_rope), q_pos.reshape(nb, qb)))
    return jnp.moveaxis(out, 0, 1).reshape(B, T, H, C)


def memory_attention(xq, mem_k, mem_v):
    s = jnp.einsum('bthd,bmhd->bhtm', xq, mem_k).astype(F32) * (X_DIM ** -0.5)
    p = jax.nn.softmax(s, axis=-1).astype(mem_v.dtype)
    return jnp.einsum('bhtm,bmhd->bthd', p, mem_v)


def gated_linear_recurrence(q, k, v, logf, s0, chunk):
    B, T, H, K = q.shape
    V = v.shape[-1]
    n = T // chunk
    blk = lambda a: a.astype(F32).reshape((B, n, chunk) + a.shape[2:])
    q, k, v, logf = blk(q), blk(k), blk(v), blk(logf)
    b = jnp.cumsum(logf, axis=2)
    ref = b[:, :, chunk // 2][:, :, None]
    b_last = b[:, :, -1]
    causal = jnp.tril(jnp.ones((chunk, chunk), dtype=bool))
    a = jnp.einsum('bnthk,bnshk->bnhts', q * jnp.exp(b - ref), k * jnp.exp(ref - b))
    a = jnp.where(causal, a, 0.0)
    o_intra = jnp.einsum('bnhts,bnshv->bnthv', a, v)
    u = jnp.einsum('bnshk,bnshv->bnhkv', k * jnp.exp(b_last[:, :, None] - b), v)
    decay = jnp.exp(b_last)

    def step(s, xs):
        d, uc = xs
        return d[..., None] * s + uc, s

    s_fin, s_in = lax.scan(step, s0.astype(F32),
                           (jnp.moveaxis(decay, 1, 0), jnp.moveaxis(u, 1, 0)))
    o_inter = jnp.einsum('bnthk,nbhkv->bnthv', q * jnp.exp(b), s_in)
    o = (o_intra + o_inter).reshape(B, T, H, V)
    return o, s_fin


def hgrn2_mixer(proj, lb, s0, o_norm_g):
    B, T, _ = proj.shape
    q, f, i, g = jnp.split(proj, 4, axis=-1)
    heads = lambda a: a.reshape(B, T, HG_HEADS, HG_DIM)
    ff = f.astype(F32)
    lbf = lb.astype(F32)
    forget = lbf + (1.0 - lbf) * jax.nn.sigmoid(ff)
    logf = jnp.log(forget)
    k = (1.0 - lbf) * jax.nn.sigmoid(-ff)
    chunk = CHUNK if T % CHUNK == 0 else T
    o, s_fin = gated_linear_recurrence(heads(jax.nn.silu(q)), heads(k), heads(i), heads(logf), s0, chunk)
    o = rmsnorm(o.astype(proj.dtype), o_norm_g) * heads(jax.nn.silu(g))
    return o.reshape(B, T, HG_WIDTH), s_fin.astype(s0.dtype)


def trunk(x, pos, past_lat, past_krope, hgrn_s0, mem_k, mem_v,
          ln_mix_pre, ln_mix_post, ln_ffn_pre, ln_ffn_post,
          mla_w_in, mla_q_norm, mla_kv_norm, mla_w_uq, mla_w_uk, mla_w_uv, mla_w_out,
          hgrn_w_in, hgrn_lb, hgrn_o_norm, hgrn_w_out, w_ffn_up, w_ffn_down):
    B, T, _ = x.shape
    lb_soft = jax.nn.softmax(hgrn_lb.astype(F32), axis=0)
    lb_all = jnp.cumsum(lb_soft, axis=0) - lb_soft[0]
    new_lat, new_krope, new_state = [], [], []
    for l in range(DEPTH):
        j = l // 2
        h = rmsnorm(x, ln_mix_pre[l])
        if l % 2 == 0:
            proj = h @ mla_w_in[j]
            c_q = proj[..., :MLA_Q_RANK]
            c_kv = proj[..., MLA_Q_RANK:MLA_Q_RANK + MLA_KV_RANK]
            k_r = proj[..., MLA_Q_RANK + MLA_KV_RANK:MLA_IN]
            xq = proj[..., MLA_IN:]
            q = (rmsnorm(c_q, mla_q_norm[j]) @ mla_w_uq[j]).reshape(B, T, MLA_HEADS, MLA_NOPE + MLA_ROPE)
            q_nope = q[..., :MLA_NOPE]
            q_rope = rope(q[..., MLA_NOPE:], pos)
            lat = rmsnorm(c_kv, mla_kv_norm[j])
            krope = rope(k_r, pos)
            q_lat = jnp.einsum('bthd,chd->bthc', q_nope, mla_w_uk[j])
            if past_lat is None:
                lat_all, krope_all = lat, krope
            else:
                lat_all = jnp.concatenate([past_lat[j], lat], axis=1)
                krope_all = jnp.concatenate([past_krope[j], krope], axis=1)
            o_lat = mla_attention(q_lat, q_rope, lat_all, krope_all, pos)
            mix = jnp.einsum('bthc,chv->bthv', o_lat, mla_w_uv[j]).reshape(B, T, MLA_OUT)
            w_out = mla_w_out[j]
            new_lat.append(lat)
            new_krope.append(krope)
        else:
            proj = h @ hgrn_w_in[j]
            mix, s_fin = hgrn2_mixer(proj[..., :4 * HG_WIDTH], lb_all[l], hgrn_s0[j], hgrn_o_norm[j])
            xq = proj[..., 4 * HG_WIDTH:]
            w_out = hgrn_w_out[j]
            new_state.append(s_fin)
        cross = memory_attention(xq.reshape(B, T, X_HEADS, X_DIM), mem_k[l], mem_v[l]).reshape(B, T, X_WIDTH)
        x = x + rmsnorm(jnp.concatenate([mix, cross], axis=-1) @ w_out, ln_mix_post[l])
        h = rmsnorm(x, ln_ffn_pre[l])
        x = x + rmsnorm(jnp.square(jax.nn.relu(h @ w_ffn_up[l])) @ w_ffn_down[l], ln_ffn_post[l])
    return x, jnp.stack(new_lat), jnp.stack(new_krope), jnp.stack(new_state)


def setup_inputs(seed: int = 0) -> dict:
    key = jax.random.key(seed)
    ks = jax.random.split(key, 32)
    nrm = lambda k, shape, scale: jax.random.normal(k, shape, F32) * scale
    gain = lambda k, shape: 1.0 + 0.05 * jax.random.normal(k, shape, F32)
    return {
        'x_prompt': nrm(ks[0], (BATCH, SEQ, D_MODEL), 1.0),
        'x_sample': nrm(ks[1], (DEC_BATCH, DEC_SEQ, D_MODEL), 1.0),
        'cache_mla_latent': nrm(ks[2], (N_MLA_LAYERS, DEC_BATCH, PAST_LEN, MLA_KV_RANK), 1.0),
        'cache_mla_krope': nrm(ks[3], (N_MLA_LAYERS, DEC_BATCH, PAST_LEN, MLA_ROPE), 1.0),
        'cache_hgrn_state': nrm(ks[4], (N_HGRN_LAYERS, DEC_BATCH, HG_HEADS, HG_DIM, HG_DIM), 0.3),
        'cache_mem_k': nrm(ks[5], (DEPTH, DEC_BATCH, N_MEM, X_HEADS, X_DIM), 1.0),
        'cache_mem_v': nrm(ks[6], (DEPTH, DEC_BATCH, N_MEM, X_HEADS, X_DIM), 1.0),
        'mem_prompt': nrm(ks[7], (BATCH, N_MEM, D_MODEL), 1.0),
        'ln_mix_pre': gain(ks[8], (DEPTH, D_MODEL)),
        'ln_mix_post': gain(ks[9], (DEPTH, D_MODEL)),
        'ln_ffn_pre': gain(ks[10], (DEPTH, D_MODEL)),
        'ln_ffn_post': gain(ks[11], (DEPTH, D_MODEL)),
        'mem_norm': gain(ks[12], (DEPTH, D_MODEL)),
        'w_mem_kv': nrm(ks[13], (DEPTH, D_MODEL, 2 * X_WIDTH), D_MODEL ** -0.5),
        'mla_w_in': nrm(ks[14], (N_MLA_LAYERS, D_MODEL, MLA_IN + X_WIDTH), D_MODEL ** -0.5),
        'mla_q_norm': gain(ks[15], (N_MLA_LAYERS, MLA_Q_RANK)),
        'mla_kv_norm': gain(ks[16], (N_MLA_LAYERS, MLA_KV_RANK)),
        'mla_w_uq': nrm(ks[17], (N_MLA_LAYERS, MLA_Q_RANK, MLA_HEADS * (MLA_NOPE + MLA_ROPE)), MLA_Q_RANK ** -0.5),
        'mla_w_uk': nrm(ks[18], (N_MLA_LAYERS, MLA_KV_RANK, MLA_HEADS, MLA_NOPE), MLA_KV_RANK ** -0.5),
        'mla_w_uv': nrm(ks[19], (N_MLA_LAYERS, MLA_KV_RANK, MLA_HEADS, MLA_V), MLA_KV_RANK ** -0.5),
        'mla_w_out': nrm(ks[20], (N_MLA_LAYERS, MIX_OUT, D_MODEL), MIX_OUT ** -0.5),
        'hgrn_w_in': nrm(ks[21], (N_HGRN_LAYERS, D_MODEL, 4 * HG_WIDTH + X_WIDTH), D_MODEL ** -0.5),
        'hgrn_lb': nrm(ks[22], (DEPTH, HG_WIDTH), 0.1),
        'hgrn_o_norm': gain(ks[23], (N_HGRN_LAYERS, HG_DIM)),
        'hgrn_w_out': nrm(ks[24], (N_HGRN_LAYERS, MIX_OUT, D_MODEL), MIX_OUT ** -0.5),
        'w_ffn_up': nrm(ks[25], (DEPTH, D_MODEL, D_FF), D_MODEL ** -0.5),
        'w_ffn_down': nrm(ks[26], (DEPTH, D_FF, D_MODEL), D_FF ** -0.5),
    }


def reference(x_prompt, x_sample, cache_mla_latent, cache_mla_krope, cache_hgrn_state,
              cache_mem_k, cache_mem_v, mem_prompt,
              ln_mix_pre, ln_mix_post, ln_ffn_pre, ln_ffn_post, mem_norm, w_mem_kv,
              mla_w_in, mla_q_norm, mla_kv_norm, mla_w_uq, mla_w_uk, mla_w_uv, mla_w_out,
              hgrn_w_in, hgrn_lb, hgrn_o_norm, hgrn_w_out, w_ffn_up, w_ffn_down):
    Bp, Tp, _ = x_prompt.shape
    Bs, Ts, _ = x_sample.shape
    past = cache_mla_latent.shape[2]
    mem_n = rmsnorm(mem_prompt[None], mem_norm[:, None, None, :])
    kv = jnp.einsum('lbmd,lde->lbme', mem_n, w_mem_kv).reshape(DEPTH, Bp, N_MEM, 2, X_HEADS, X_DIM)
    mem_k_p, mem_v_p = kv[:, :, :, 0], kv[:, :, :, 1]
    weights = (ln_mix_pre, ln_mix_post, ln_ffn_pre, ln_ffn_post,
               mla_w_in, mla_q_norm, mla_kv_norm, mla_w_uq, mla_w_uk, mla_w_uv, mla_w_out,
               hgrn_w_in, hgrn_lb, hgrn_o_norm, hgrn_w_out, w_ffn_up, w_ffn_down)
    s0_p = jnp.zeros((N_HGRN_LAYERS, Bp, HG_HEADS, HG_DIM, HG_DIM), x_prompt.dtype)
    y_p, lat_p, kr_p, st_p = trunk(x_prompt, jnp.arange(Tp), None, None, s0_p,
                                   mem_k_p, mem_v_p, *weights)
    y_s, lat_s, kr_s, st_s = trunk(x_sample, past + jnp.arange(Ts), cache_mla_latent, cache_mla_krope,
                                   cache_hgrn_state, cache_mem_k, cache_mem_v, *weights)
    return (y_p, y_s, lat_p, kr_p, st_p, mem_k_p, mem_v_p, lat_s, kr_s, st_s)
```

```cpp
#include <hip/hip_runtime.h>
#include <hip/hip_cooperative_groups.h>
#include <stdint.h>
#include <math.h>
#include <stdio.h>
#include <string.h>
namespace cg = cooperative_groups;

#define DI __device__ __forceinline__
typedef unsigned short u16;
typedef __attribute__((ext_vector_type(8))) short bf16x8;
typedef __attribute__((ext_vector_type(4))) short s16x4;
typedef __attribute__((ext_vector_type(16))) float f32x16;
#define MFMA(a, b, c) __builtin_amdgcn_mfma_f32_32x32x16_bf16((a), (b), (c), 0, 0, 0)

constexpr int NP = 16384, NS = 2048, NT = NP + NS, NKV = NP + 32 * 1088;
constexpr int NCHUNK = NT / 64;
constexpr float EPS = 1e-6f;
constexpr float LOG2E = 1.4426950408889634f;
constexpr float QSCALE = 0.07216878364870322f * LOG2E;
constexpr float XSCALE = 0.08838834764831845f * LOG2E;

constexpr long O_Y = 0, O_LATP = 18874368, O_KRP = 23068672, O_HGP = 24117248, O_MKP = 24248320,
               O_MVP = 24510464, O_LATS = 24772608, O_KRS = 25296896, O_HGS = 25427968;

constexpr size_t MiB = 1048576;
constexpr size_t WS_NEED = 304 * MiB;
constexpr size_t W_QCNT = 16384;
constexpr size_t W_RS = 0x10000, W_RSMEM = 0x30000, W_LBV = 0x31000, W_DECAY = 0x40000;
constexpr size_t W_MEMKP = 3 * MiB, W_MEMVTP = 3 * MiB + MiB / 2;
constexpr size_t W_IN0T = 4 * MiB, W_UQT = 6 * MiB + MiB / 2, W_UKT = 7 * MiB + 3 * MiB / 4, W_UVT = 8 * MiB + MiB / 4,
                 W_OUT0T = 8 * MiB + 3 * MiB / 4, W_MEMT = 12 * MiB, W_ROPE = 16 * MiB, W_MEMB = 20 * MiB,
                 W_XB0 = 21 * MiB, W_LATALL = 57 * MiB, W_KRALL = 82 * MiB, W_MEMKS0 = 89 * MiB, W_MEMVTS0 = 97 * MiB,
                 W_P0F = 105 * MiB, W_CQN = 281 * MiB, W_XQ0 = 209 * MiB, W_Q = 227 * MiB, W_KNP = 105 * MiB,
                 W_VTP = 137 * MiB, W_KNS = 169 * MiB, W_VTS = 21 * MiB, W_Y7 = 105 * MiB, W_UP0T = 220 * MiB, W_DOWN0T = 228 * MiB, W_HID0 = 76 * MiB,
                 W_Y10 = 4 * MiB;
constexpr size_t W_XB1 = 256 * MiB, W_IN1T = 292 * MiB, W_OUT1T = 301 * MiB, W_QS = 4 * MiB, W_F = 40 * MiB,
                 W_V = 112 * MiB, W_GS = 148 * MiB, W_XQ1 = 184 * MiB, W_U = 202 * MiB, W_MEMKS1 = 112 * MiB,
                 W_MEMVTS1 = 120 * MiB, W_Y16 = 40 * MiB, W_XB2 = 4 * MiB, W_UP1T = 112 * MiB, W_DOWN1T = 120 * MiB,
                 W_HID1 = 128 * MiB, W_Y19 = 40 * MiB;
constexpr size_t W_PART7 = 177 * MiB, W_PART10 = 236 * MiB, W_PART16 = 148 * MiB, W_PART19 = 272 * MiB;

struct Params {
  const float* in[27];
  float* out;
  char* ws;
  double inv_freq[32];
  int never;
  int pad;
};
enum { I_XP = 0, I_XS, I_CLAT, I_CKR, I_CHS, I_CMK, I_CMV, I_MEMP, I_LMPRE, I_LMPOST, I_LFPRE, I_LFPOST, I_MEMNORM,
       I_WMEMKV, I_WIN0, I_QNORM, I_KVNORM, I_WUQ, I_WUK, I_WUV, I_WOUT0, I_WIN1, I_LB, I_ONORM, I_WOUT1, I_WUP, I_WDOWN };

typedef __bf16 bf16v2_t __attribute__((ext_vector_type(2)));
typedef float f32v2_t __attribute__((ext_vector_type(2)));
DI unsigned pack2(float a, float b) { f32v2_t v = {a, b}; return __builtin_bit_cast(unsigned, __builtin_convertvector(v, bf16v2_t)); }
DI u16 f2bf(float x) { return (u16)(pack2(x, 0.f) & 0xffffu); }
DI float bf2f(u16 h) { return __uint_as_float(((unsigned)h) << 16); }
typedef float f32x4n __attribute__((ext_vector_type(4)));
DI float4 ld_nt4(const float* q) { const f32x4n v = __builtin_nontemporal_load((const f32x4n*)q); return make_float4(v.x, v.y, v.z, v.w); }
typedef unsigned u32x2n __attribute__((ext_vector_type(2)));
typedef unsigned u32x4n __attribute__((ext_vector_type(4)));
DI uint2 ld_nt2u(const void* q) { const u32x2n v = __builtin_nontemporal_load((const u32x2n*)q); return make_uint2(v.x, v.y); }
DI uint4 ld_nt4u(const void* q) { const u32x4n v = __builtin_nontemporal_load((const u32x4n*)q); return make_uint4(v.x, v.y, v.z, v.w); }
DI void st_nt4(float* q, float4 v) { f32x4n t = {v.x, v.y, v.z, v.w}; __builtin_nontemporal_store(t, (f32x4n*)q); }
DI float wave_sum(float v) {
#pragma unroll
  for (int o = 32; o >= 1; o >>= 1) v += __shfl_xor(v, o);
  return v;
}
DI char* launder(char* q) { return q; }
DI int opaque_tid() { int t = threadIdx.x; asm volatile("" : "+v"(t)); return t; }
DI int crow(int i, int h) { return (i & 3) + 8 * (i >> 2) + 4 * h; }
DI float sigmoidf_(float x) { return __builtin_amdgcn_rcpf(1.f + __expf(-x)); }
DI float siluf_(float x) { return x * __builtin_amdgcn_rcpf(1.f + __expf(-x)); }

#define XB_TMO      128
#define XB_XCNT(j)  (256  + 64 * (j))
#define XB_XSUB(j)  (1280 + 64 * (j))
#define XB_XGEN(j)  (2304 + 64 * (j))
#define XB_TOP      3328
#define XB_TOPGEN   3392
#define XCD_BAR_WORDS 3456
#define XB_SPIN_CAP (1u << 23)
#define LAS __attribute__((address_space(3)))
DI unsigned xb_ld(unsigned* p) { return __hip_atomic_load(p, __ATOMIC_RELAXED, __HIP_MEMORY_SCOPE_AGENT); }
DI unsigned xb_add(unsigned* p, unsigned v) { return __hip_atomic_fetch_add(p, v, __ATOMIC_RELAXED, __HIP_MEMORY_SCOPE_AGENT); }
DI unsigned xb_xcc_id() { return (unsigned)__builtin_amdgcn_s_getreg((3 << 11) | 20) & 0xFu; }
#define XB_SPIN(cond, bar) do { unsigned _sp = 0; while (cond) { __builtin_amdgcn_s_sleep(1); \
    if ((++_sp & 255u) == 0u) { if (xb_ld(&(bar)[XB_TMO])) break; if (_sp > XB_SPIN_CAP) { atomicAdd(&(bar)[XB_TMO], 1u); break; } } } } while (0)
struct XcdBarrier { unsigned* bar; unsigned x; volatile LAS unsigned* st; };
DI XcdBarrier xcd_barrier_post(unsigned* bar, volatile LAS unsigned* st) {
  XcdBarrier b; b.bar = bar; b.x = xb_xcc_id(); b.st = st;
  if (threadIdx.x == 0) (void)xb_add(&bar[XB_XCNT(b.x)], 1u);
  return b;
}
DI void xcd_barrier_complete(unsigned* bar, unsigned x, unsigned& nloc, unsigned& nx) {
  const unsigned G = gridDim.x * gridDim.y * gridDim.z;
  unsigned sum, cnt, mine, sp = 0u;
  for (;;) {
    sum = 0u; cnt = 0u; mine = 0u;
#pragma unroll
    for (unsigned j = 0; j < 16; ++j) { const unsigned c = xb_ld(&bar[XB_XCNT(j)]); sum += c; cnt += (c > 0u) ? 1u : 0u; mine = (j == x) ? c : mine; }
    if (sum == G) break;
    __builtin_amdgcn_s_sleep(1);
    if ((++sp & 255u) == 0u) { if (xb_ld(&bar[XB_TMO])) break; if (sp > XB_SPIN_CAP) { atomicAdd(&bar[XB_TMO], 1u); break; } }
  }
  nloc = mine > 0u ? mine : 1u; nx = cnt > 0u ? cnt : 1u;
}
DI void xcd_barrier(const XcdBarrier& b) {
  asm volatile("s_waitcnt vmcnt(0)" ::: "memory");
  __syncthreads();
  if (threadIdx.x == 0) {
    unsigned* bar = b.bar;
    __builtin_amdgcn_s_waitcnt(0);
    unsigned nloc = b.st[0], nx = b.st[1];
    if (nloc == 0u) { xcd_barrier_complete(bar, b.x, nloc, nx); b.st[0] = nloc; b.st[1] = nx; }
    const unsigned old = xb_add(&bar[XB_XSUB(b.x)], 1u);
    const unsigned gen = old / nloc;
    if (old + 1u == (gen + 1u) * nloc) {
      __builtin_amdgcn_fence(__ATOMIC_RELEASE, "agent");
      asm volatile("s_waitcnt vmcnt(0)" ::: "memory");
      const unsigned og = xb_add(&bar[XB_TOP], 1u);
      const unsigned tg = og / nx;
      if (og + 1u == (tg + 1u) * nx) xb_add(&bar[XB_TOPGEN], 1u);
      else XB_SPIN(xb_ld(&bar[XB_TOPGEN]) == tg, bar);
      __builtin_amdgcn_fence(__ATOMIC_ACQUIRE, "agent");
      xb_add(&bar[XB_XGEN(b.x)], 1u);
      asm volatile("s_waitcnt vmcnt(0)" ::: "memory");
    } else {
      XB_SPIN(xb_ld(&bar[XB_XGEN(b.x)]) == gen, bar);
      __builtin_amdgcn_fence(__ATOMIC_ACQUIRE, "agent");
      asm volatile("s_waitcnt vmcnt(0)" ::: "memory");
    }
  }
  __syncthreads();
}

constexpr int SMEM_MAIN = 73728;
constexpr int SMEM_TOTAL = SMEM_MAIN + 256;

DI void tr_tile(const float* __restrict__ src, long ld_src, int N, const float* __restrict__ gain,
                u16* __restrict__ dst, long ld_dst, int kt, int nt, float* tile  ) {
  const int tid = opaque_tid();
  const bool inside = nt * 64 < N;
  float4 v[4];
#pragma unroll
  for (int j = 0; j < 4; j++) {
    const int idx = tid + 256 * j, r = idx >> 4, c4 = idx & 15;
    v[j] = make_float4(0.f, 0.f, 0.f, 0.f);
    if (inside) {
      v[j] = ld_nt4(src + (long)(kt * 64 + r) * ld_src + nt * 64 + c4 * 4);
      if (gain) { const float g = gain[kt * 64 + r]; v[j].x *= g; v[j].y *= g; v[j].z *= g; v[j].w *= g; }
    }
  }
#pragma unroll
  for (int j = 0; j < 4; j++) {
    const int idx = tid + 256 * j, r = idx >> 4, c4 = idx & 15;
    float* tp = tile + r * 65 + c4 * 4;
    tp[0] = v[j].x; tp[1] = v[j].y; tp[2] = v[j].z; tp[3] = v[j].w;
  }
  __syncthreads();
#pragma unroll
  for (int j = 0; j < 2; j++) {
    const int idx = tid + 256 * j, rn = idx >> 3, ck = idx & 7;
    const float* tp = tile + (ck * 8) * 65 + rn;
    uint4 o;
    o.x = pack2(tp[0], tp[65]); o.y = pack2(tp[2 * 65], tp[3 * 65]); o.z = pack2(tp[4 * 65], tp[5 * 65]); o.w = pack2(tp[6 * 65], tp[7 * 65]);
    *(uint4*)(dst + (long)(nt * 64 + rn) * ld_dst + kt * 64 + ck * 8) = o;
  }
  __syncthreads();
}
DI void convert_weight(const float* src, int K, int N, int Npad, const float* gain, u16* dst, char* smem, int rot = 0) {
  const int nkt = K / 64, nnt = Npad / 64;
  const int b0 = (int)((blockIdx.x + gridDim.x - (unsigned)rot % gridDim.x) % gridDim.x);
  for (int i = b0; i < nkt * nnt; i += gridDim.x) tr_tile(src, N, N, gain, dst, K, i % nkt, i / nkt, (float*)smem);
}
DI void convert_mem_cache(const Params& p, int l, u16* memk_s, u16* memvT_s, char* smem) {
  const float* ck = p.in[I_CMK] + (long)l * 32 * 256 * 512;
  const long n4 = 32L * 256 * 512 / 4;
  const int tid = opaque_tid();
  for (long i = (long)blockIdx.x * 256 + tid; i < n4; i += (long)gridDim.x * 256) {
    const float4 v = ld_nt4(ck + i * 4);
    uint2 o; o.x = pack2(v.x, v.y); o.y = pack2(v.z, v.w);
    ((uint2*)memk_s)[i] = o;
  }
  const float* cv = p.in[I_CMV] + (long)l * 32 * 256 * 512;
  for (int i = blockIdx.x; i < 128 * 8; i += gridDim.x) {
    const int bh = i >> 3, t = i & 7, b = bh >> 2, h = bh & 3;
    tr_tile(cv + (long)b * 256 * 512 + h * 128, 512, 128, nullptr, memvT_s + (long)bh * 128 * 256, 256, t & 3, t >> 2, (float*)smem);
  }
}

template <class AL, class BL>
DI void gemm_core(AL al, BL bl, int m0, int n0, int K, char* smem, f32x16 (&acc)[2][2]) {
  const int tid = opaque_tid(), lane = tid & 63, w = tid >> 6, wm = w >> 1, wn = w & 1;
  u16* As = (u16*)smem;
  u16* Bs = As + 2 * 128 * 72;
  uint4 xa0, xa1, xa2, xa3, xb0, xb1, xb2, xb3, ya0, ya1, ya2, ya3, yb0, yb1, yb2, yb3;
  const int nk = K / 64;
#pragma unroll
  for (int mt = 0; mt < 2; mt++)
#pragma unroll
    for (int nt = 0; nt < 2; nt++)
#pragma unroll
      for (int i = 0; i < 16; i++) acc[mt][nt][i] = 0.f;
  const int srow = tid >> 3, sch = tid & 7;
#define G_LD1(RA, RB, i_, kt_) RA = *(const uint4*)al(m0 + srow + 32 * (i_), (kt_) * 64 + sch * 8); RB = *(const uint4*)bl(n0 + srow + 32 * (i_), (kt_) * 64 + sch * 8)
#define G_LOAD(S, kt_) do { G_LD1(S##a0, S##b0, 0, kt_); G_LD1(S##a1, S##b1, 1, kt_); G_LD1(S##a2, S##b2, 2, kt_); G_LD1(S##a3, S##b3, 3, kt_); } while (0)
#define G_ST1(RA, RB, i_, buf_) *(uint4*)(As + ((buf_) * 128 + srow + 32 * (i_)) * 72 + sch * 8) = RA; *(uint4*)(Bs + ((buf_) * 128 + srow + 32 * (i_)) * 72 + sch * 8) = RB
#define G_STORE(S, buf_) do { G_ST1(S##a0, S##b0, 0, buf_); G_ST1(S##a1, S##b1, 1, buf_); G_ST1(S##a2, S##b2, 2, buf_); G_ST1(S##a3, S##b3, 3, buf_); } while (0)
#define G_FRAG(AF, BF, buf_, ks_) do { \
    const u16* Ab = As + (buf_) * 128 * 72; const u16* Bb = Bs + (buf_) * 128 * 72; \
    AF[0] = *(const bf16x8*)(Ab + (wm * 64 + (lane & 31)) * 72 + (ks_) * 16 + (lane >> 5) * 8); \
    AF[1] = *(const bf16x8*)(Ab + (wm * 64 + 32 + (lane & 31)) * 72 + (ks_) * 16 + (lane >> 5) * 8); \
    BF[0] = *(const bf16x8*)(Bb + (wn * 64 + (lane & 31)) * 72 + (ks_) * 16 + (lane >> 5) * 8); \
    BF[1] = *(const bf16x8*)(Bb + (wn * 64 + 32 + (lane & 31)) * 72 + (ks_) * 16 + (lane >> 5) * 8); } while (0)
#define G_MMA(AF, BF) do { \
    acc[0][0] = MFMA(AF[0], BF[0], acc[0][0]); acc[0][1] = MFMA(AF[0], BF[1], acc[0][1]); \
    acc[1][0] = MFMA(AF[1], BF[0], acc[1][0]); acc[1][1] = MFMA(AF[1], BF[1], acc[1][1]); } while (0)
#define G_STEP(buf_, S, ks_, AF, BF, AN, BN, do_st, do_ld, ktn_) do { \
    if ((ks_) < 3) G_FRAG(AN, BN, buf_, (ks_) + 1); \
    G_MMA(AF, BF); \
    if (do_st) { G_ST1(S##a##ks_, S##b##ks_, ks_, (buf_) ^ 1); } \
    if (do_ld) { G_LD1(S##a##ks_, S##b##ks_, ks_, ktn_); } \
    __builtin_amdgcn_sched_barrier(0); } while (0)
#define G_TILE(buf_, S, do_st, do_ld, ktn_) do { \
    bf16x8 fa0[2], fb0[2], fa1[2], fb1[2]; \
    G_FRAG(fa0, fb0, buf_, 0); \
    G_STEP(buf_, S, 0, fa0, fb0, fa1, fb1, do_st, do_ld, ktn_); \
    G_STEP(buf_, S, 1, fa1, fb1, fa0, fb0, do_st, do_ld, ktn_); \
    G_STEP(buf_, S, 2, fa0, fb0, fa1, fb1, do_st, do_ld, ktn_); \
    G_STEP(buf_, S, 3, fa1, fb1, fa0, fb0, do_st, do_ld, ktn_); } while (0)
  G_LOAD(x, 0);
  G_STORE(x, 0);
  G_LOAD(x, 1);
  G_LOAD(y, (nk > 2) ? 2 : 1);
  __syncthreads();
  for (int kt = 0; kt < nk; kt += 2) {
    G_TILE(0, x, true, (kt + 3 < nk), kt + 3);
    __syncthreads();
    G_TILE(1, y, (kt + 2 < nk), (kt + 4 < nk), kt + 4);
    __syncthreads();
  }
#undef G_LD1
#undef G_ST1
#undef G_LOAD
#undef G_STORE
#undef G_FRAG
#undef G_MMA
#undef G_STEP
#undef G_TILE
}
template <class F>
DI void epi_each(const f32x16 (&acc)[2][2], int m0, int n0, F f) {
  const int tid = opaque_tid(), lane = tid & 63, w = tid >> 6, wm = w >> 1, wn = w & 1, h = lane >> 5;
#pragma unroll
  for (int mt = 0; mt < 2; mt++)
#pragma unroll
    for (int nt = 0; nt < 2; nt++)
#pragma unroll
      for (int i = 0; i < 16; i++)
        f(m0 + wm * 64 + mt * 32 + crow(i, h), n0 + wn * 64 + nt * 32 + (lane & 31), acc[mt][nt][i]);
}

template <class F>
DI void epi_bf16_tile(const f32x16 (&acc)[2][2], int m0, int n0, u16* dst0, long ld, char* smem, F f) {
  const int tid = opaque_tid(), lane = tid & 63, w = tid >> 6, wm = w >> 1, wn = w & 1, h = lane >> 5;
  u16* T = (u16*)smem;
#pragma unroll
  for (int mt = 0; mt < 2; mt++)
#pragma unroll
    for (int nt = 0; nt < 2; nt++)
#pragma unroll
      for (int i = 0; i < 16; i++) {
        const int ml = wm * 64 + mt * 32 + crow(i, h), nl = wn * 64 + nt * 32 + (lane & 31);
        T[ml * 136 + nl] = f2bf(f(m0 + ml, n0 + nl, acc[mt][nt][i]));
      }
  __syncthreads();
#pragma unroll
  for (int j = 0; j < 8; j++) {
    const int idx = tid + 256 * j, row = idx >> 4, ch = idx & 15;
    *(uint4*)(dst0 + (long)row * ld + ch * 8) = *(const uint4*)(T + row * 136 + ch * 8);
  }
  __syncthreads();
}

template <class F>
DI void epi_bf16_vtile(const f32x16 (&acc)[2][2], u16* dst0  , char* smem, F f) {
  const int tid = opaque_tid(), lane = tid & 63, w = tid >> 6, wm = w >> 1, wn = w & 1, h = lane >> 5;
  u16* T = (u16*)smem;
#pragma unroll
  for (int mt = 0; mt < 2; mt++)
#pragma unroll
    for (int nt = 0; nt < 2; nt++)
#pragma unroll
      for (int i = 0; i < 16; i++) {
        const int ml = wm * 64 + mt * 32 + crow(i, h), nl = wn * 64 + nt * 32 + (lane & 31);
        T[ml * 136 + nl] = f2bf(f(acc[mt][nt][i]));
      }
  __syncthreads();
#pragma unroll
  for (int j = 0; j < 8; j++) {
    const int idx = tid + 256 * j, row = idx >> 4, ch = idx & 15;
    *(uint4*)(dst0 + ((long)(ch >> 3) * 128 + row) * 64 + (ch & 7) * 8) = *(const uint4*)(T + row * 136 + ch * 8);
  }
  __syncthreads();
}

template <int DQK>
DI void attn_item(const u16* Qb, long ldq, const u16* K1, long ldk1, const u16* K2, long ldk2,
                  const u16* VT, long ldvt, int nkt, int nkt_w, u16* Ob, long ldo, char* smem, bool rev = false, int vtile = 64) {
  constexpr int KLD = DQK + 8;
  constexpr int NCH = DQK / 8;
  constexpr int NKC = 64 * NCH / 256;
  constexpr int NQF = DQK / 16;
  u16* Ks = (u16*)smem;
  u16* Vs = Ks + 64 * KLD;
  int tid_ = threadIdx.x;
  asm volatile("" : "+v"(tid_));
  const int tid = tid_, lane = tid & 63, w = tid >> 6, h = lane >> 5, r = lane & 31;
  constexpr int NQR = (NQF > 8) ? 8 : NQF;
  bf16x8 qf[NQR];
  const u16* qp = Qb + (long)(w * 32 + r) * ldq + h * 8;
  if (nkt_w > 0) {
#pragma unroll
    for (int ks = 0; ks < NQR; ks++) qf[ks] = *(const bf16x8*)(qp + ks * 16);
  } else {
#pragma unroll
    for (int ks = 0; ks < NQR; ks++) qf[ks] = (bf16x8){0, 0, 0, 0, 0, 0, 0, 0};
  }
  u16* Qs = Vs + 128 * 68;
  if (NQF > NQR) {
    const int qrow = tid >> 1, qhalf = tid & 1;
    const bool qvalid = (nkt_w > 0) || (qrow < 64);
    const u16* qsrc = Qb + (long)qrow * ldq + NQR * 16 + qhalf * 32;
#pragma unroll
    for (int c = 0; c < 4; c++) {
      uint4 v = make_uint4(0, 0, 0, 0);
      if (qvalid) v = *(const uint4*)(qsrc + c * 8);
      *(uint4*)(Qs + qrow * 72 + qhalf * 32 + c * 8) = v;
    }
  }
  f32x16 o[4];
#pragma unroll
  for (int mc = 0; mc < 4; mc++)
#pragma unroll
    for (int i = 0; i < 16; i++) o[mc][i] = 0.f;
  float m_run = -1e30f, l_run = 0.f;
  uint4 rk0, rk1, rk2, rk3, rk4 = make_uint4(0, 0, 0, 0), rk5 = make_uint4(0, 0, 0, 0), rv0, rv1, rv2, rv3;
  const unsigned voffK = (unsigned)(((tid >> 4) * (int)ldk1 + (tid & 15) * 8) * 2);
  const unsigned voffR = (unsigned)(((tid >> 3) * (int)ldk2 + (tid & 7) * 8) * 2);
  const unsigned voffV = (unsigned)(((tid >> 3) * (int)ldvt + (tid & 7) * 8) * 2);
  u16* const ldsK = Ks + (tid >> 4) * KLD + (tid & 15) * 8;
  u16* const ldsR = Ks + (tid >> 3) * KLD + (16 + (tid & 7)) * 8;
  u16* const ldsV = Vs + (tid >> 3) * 68 + (tid & 7) * 8;
#define ATT_KP(i_, kt_) ((const char*)K1 + ((long)((kt_) * 64 + 16 * (i_)) * ldk1) * 2 + voffK)
#define ATT_RP(i_, kt_) ((const char*)K2 + ((long)((kt_) * 64 + 32 * (i_)) * ldk2) * 2 + voffR)
#define ATT_VP(i_, kt_) ((const char*)VT + ((long)(32 * (i_)) * ldvt + (long)(kt_) * vtile) * 2 + voffV)
#define ATT_GLOAD(kt_) do { \
    rk0 = *(const uint4*)ATT_KP(0, kt_); rk1 = *(const uint4*)ATT_KP(1, kt_); \
    rk2 = *(const uint4*)ATT_KP(2, kt_); rk3 = *(const uint4*)ATT_KP(3, kt_); \
    if (DQK == 192) { rk4 = *(const uint4*)ATT_RP(0, kt_); rk5 = *(const uint4*)ATT_RP(1, kt_); } \
    rv0 = *(const uint4*)ATT_VP(0, kt_); rv1 = *(const uint4*)ATT_VP(1, kt_); \
    rv2 = *(const uint4*)ATT_VP(2, kt_); rv3 = *(const uint4*)ATT_VP(3, kt_); } while (0)
#define ATT_VST(i_, v_) do { uint2* d_ = (uint2*)(ldsV + 32 * (i_) * 68); \
    d_[0] = make_uint2((v_).x, (v_).y); d_[1] = make_uint2((v_).z, (v_).w); } while (0)
#define ATT_SSTORE() do { \
    *(uint4*)(ldsK) = rk0; *(uint4*)(ldsK + 16 * KLD) = rk1; *(uint4*)(ldsK + 32 * KLD) = rk2; *(uint4*)(ldsK + 48 * KLD) = rk3; \
    if (DQK == 192) { *(uint4*)(ldsR) = rk4; *(uint4*)(ldsR + 32 * KLD) = rk5; } \
    ATT_VST(0, rv0); ATT_VST(1, rv1); ATT_VST(2, rv2); ATT_VST(3, rv3); } while (0)
  ATT_GLOAD(rev ? nkt - 1 : 0);
  for (int kt = 0; kt < nkt; kt++) {
    __syncthreads();
    ATT_SSTORE();
    __syncthreads();
    const int ktile = rev ? nkt - 1 - kt : kt;
    const bool active = ktile < nkt_w;
    f32x16 s[2];
    if (active) {
      const f32x16 zero16 = {0.f, 0.f, 0.f, 0.f, 0.f, 0.f, 0.f, 0.f, 0.f, 0.f, 0.f, 0.f, 0.f, 0.f, 0.f, 0.f};
      bf16x8 qx[(NQF > NQR) ? (NQF - NQR) : 1];
      if (NQF > NQR) {
#pragma unroll
        for (int ks = NQR; ks < NQF; ks++) qx[ks - NQR] = *(const bf16x8*)(Qs + (w * 32 + r) * 72 + (ks - NQR) * 16 + h * 8);
      }
      __builtin_amdgcn_s_setprio(1);
#pragma unroll
      for (int ks = 0; ks < NQF; ks++) {
#pragma unroll
        for (int mt = 0; mt < 2; mt++) {
          const bf16x8 kf = *(const bf16x8*)(Ks + (mt * 32 + r) * KLD + ks * 16 + h * 8);
          s[mt] = MFMA(kf, (ks < NQR) ? qf[ks < NQR ? ks : 0] : qx[ks >= NQR ? ks - NQR : 0], (ks == 0) ? zero16 : s[mt]);
        }
        if ((ks & 3) == 3) __builtin_amdgcn_sched_barrier(0);
      }
      __builtin_amdgcn_s_setprio(0);
    }
    __builtin_amdgcn_sched_barrier(0);
    if (kt + 1 < nkt) ATT_GLOAD(rev ? ktile - 1 : ktile + 1);
    __builtin_amdgcn_sched_barrier(0);
    if (active) {
      float mx = s[0][0];
#pragma unroll
      for (int mt = 0; mt < 2; mt++)
#pragma unroll
        for (int i = 0; i < 16; i++) mx = fmaxf(mx, s[mt][i]);
      mx = fmaxf(mx, __shfl_xor(mx, 32));
      if (__builtin_amdgcn_ballot_w64(mx > m_run + 8.f) != 0ull) {
        const float m_new = fmaxf(m_run, mx);
        const float alpha = __builtin_amdgcn_exp2f(m_run - m_new);
        m_run = m_new;
        l_run *= alpha;
#pragma unroll
        for (int mc = 0; mc < 4; mc++)
#pragma unroll
          for (int i = 0; i < 16; i++) o[mc][i] *= alpha;
      }
      float sum = 0.f;
#pragma unroll
      for (int mt = 0; mt < 2; mt++)
#pragma unroll
        for (int i = 0; i < 16; i++) { const float e = __builtin_amdgcn_exp2f(s[mt][i] - m_run); s[mt][i] = e; sum += e; }
      l_run += sum;
      __builtin_amdgcn_s_setprio(1);
#pragma unroll
      for (int mt = 0; mt < 2; mt++) {
#pragma unroll
        for (int sp = 0; sp < 2; sp++) {
          const int st = 2 * mt + sp;
          unsigned pp[4];
#pragma unroll
          for (int j = 0; j < 4; j++) pp[j] = pack2(s[mt][8 * sp + 2 * j], s[mt][8 * sp + 2 * j + 1]);
          const bf16x8 pf = __builtin_bit_cast(bf16x8, make_uint4(pp[0], pp[1], pp[2], pp[3]));
#pragma unroll
          for (int mc = 0; mc < 4; mc++) {
            const u16* vp = Vs + (mc * 32 + r) * 68 + 16 * st + 4 * h;
            const uint2 lo = *(const uint2*)vp;
            const uint2 hi = *(const uint2*)(vp + 8);
            const bf16x8 vf = __builtin_bit_cast(bf16x8, make_uint4(lo.x, lo.y, hi.x, hi.y));
            o[mc] = MFMA(vf, pf, o[mc]);
          }
          __builtin_amdgcn_sched_barrier(0);
        }
      }
      __builtin_amdgcn_s_setprio(0);
    }
  }
  if (nkt_w > 0) {
    const float l = l_run + __shfl_xor(l_run, 32);
    const float inv = __builtin_amdgcn_rcpf(l);
    u16* op = Ob + (long)(w * 32 + r) * ldo;
#pragma unroll
    for (int mc = 0; mc < 4; mc++)
#pragma unroll
      for (int g = 0; g < 4; g++) {
        uint2 v;
        v.x = pack2(o[mc][4 * g] * inv, o[mc][4 * g + 1] * inv);
        v.y = pack2(o[mc][4 * g + 2] * inv, o[mc][4 * g + 3] * inv);
        *(uint2*)(op + mc * 32 + 8 * g + 4 * h) = v;
      }
  }
}

DI const float* xrow(const Params& p, int t) { return t < NP ? p.in[I_XP] + (long)t * 1024 : p.in[I_XS] + (long)(t - NP) * 1024; }
DI int tok_pos(int t) { return t < NP ? t : 1024 + ((t - NP) & 63); }
DI int tok_kv(int t) { return t < NP ? t : NP + ((t - NP) >> 6) * 1088 + 1024 + ((t - NP) & 63); }

constexpr int XR_LD = 2048;
DI u16* xres_base(const Params& p) { return (u16*)(p.out + O_Y) + 1024; }
DI void rowwise_residual(const Params& p, const u16* Y, const float* gpost, int mode, const u16* parts) {
  const int tid = opaque_tid(), lane = tid & 63, w = tid >> 6;
  float* y = p.out + O_Y;
  u16* xr = xres_base(p);
  float* rs = (float*)(p.ws + W_RS);
  const int stride = gridDim.x * 4;
  for (int tb = blockIdx.x * 4 + w; tb < NT; tb += 2 * stride) {
    float4 yv[2][4], xv[2][4];
    float ss[2] = {0.f, 0.f};
#pragma unroll
    for (int u = 0; u < 2; u++) {
      const int t = tb + u * stride;
      if (t < NT) {
#pragma unroll
        for (int j = 0; j < 4; j++) {
          const uint2 yr = ld_nt2u(Y + (long)t * 1024 + j * 256 + lane * 4);
          yv[u][j] = make_float4(bf2f((u16)(yr.x & 0xffff)), bf2f((u16)(yr.x >> 16)), bf2f((u16)(yr.y & 0xffff)), bf2f((u16)(yr.y >> 16)));
          if (mode == 0) xv[u][j] = *(const float4*)(xrow(p, t) + j * 256 + lane * 4);
          else {
            const uint2 xq_ = *(const uint2*)(xr + (long)t * XR_LD + j * 256 + lane * 4);
            xv[u][j] = make_float4(bf2f((u16)(xq_.x & 0xffff)), bf2f((u16)(xq_.x >> 16)), bf2f((u16)(xq_.y & 0xffff)), bf2f((u16)(xq_.y >> 16)));
          }
        }
        if (lane >= 32 && t >= 2048) {
#pragma unroll
          for (int q = 0; q < 3; q++) {
            const uint2 pv = ld_nt2u(parts + ((long)q * NT + t) * 128 + (lane - 32) * 4);
            yv[u][3].x += bf2f((u16)(pv.x & 0xffff)); yv[u][3].y += bf2f((u16)(pv.x >> 16));
            yv[u][3].z += bf2f((u16)(pv.y & 0xffff)); yv[u][3].w += bf2f((u16)(pv.y >> 16));
          }
        }
#pragma unroll
        for (int j = 0; j < 4; j++) ss[u] += yv[u][j].x * yv[u][j].x + yv[u][j].y * yv[u][j].y + yv[u][j].z * yv[u][j].z + yv[u][j].w * yv[u][j].w;
      }
    }
    ss[0] = wave_sum(ss[0]); ss[1] = wave_sum(ss[1]);
#pragma unroll
    for (int u = 0; u < 2; u++) {
      const int t = tb + u * stride;
      if (t < NT) {
        const float r = rsqrtf(ss[u] * (1.f / 1024.f) + EPS);
        float s2 = 0.f;
#pragma unroll
        for (int j = 0; j < 4; j++) {
          const float4 g = *(const float4*)(gpost + j * 256 + lane * 4);
          float4 xn = xv[u][j];
          xn.x += yv[u][j].x * r * g.x; xn.y += yv[u][j].y * r * g.y; xn.z += yv[u][j].z * r * g.z; xn.w += yv[u][j].w * r * g.w;
          s2 += xn.x * xn.x + xn.y * xn.y + xn.z * xn.z + xn.w * xn.w;
          if (mode == 2) st_nt4(y + (long)t * 1024 + j * 256 + lane * 4, xn);
          else {
            uint2 o; o.x = pack2(xn.x, xn.y); o.y = pack2(xn.z, xn.w);
            *(uint2*)(xr + (long)t * XR_LD + j * 256 + lane * 4) = o;
          }
        }
        if (mode != 2) {
          s2 = wave_sum(s2);
          if (lane == 0) rs[t] = rsqrtf(s2 * (1.f / 1024.f) + EPS);
        }
      }
    }
  }
}

constexpr int NSKV = 32 * 1088;
DI void attn_phase_l0(const Params& p, int g, unsigned* qcnt, char* smem) {
  char* ws = launder(p.ws);
  u16* Q = (u16*)(ws + W_Q);
  const u16* knp = (const u16*)(ws + W_KNP);
  const u16* vtp = (const u16*)(ws + W_VTP);
  const u16* kns = (const u16*)(ws + W_KNS);
  const u16* vts = (const u16*)(ws + W_VTS);
  const u16* krall = (const u16*)(ws + W_KRALL);
  u16* xq = (u16*)(ws + W_XQ0);
  const u16* memk_p = (const u16*)(ws + W_MEMKP);
  const u16* memvT_p = (const u16*)(ws + W_MEMVTP);
  const u16* memk_s = (const u16*)(ws + W_MEMKS0);
  const u16* memvT_s = (const u16*)(ws + W_MEMVTS0);
  volatile int* qslot = (volatile int*)(smem + SMEM_MAIN + 16);
  const int n_mla_p = (g == 0) ? 1024 : 0, n_mla_s = 128, n_cross = (g == 0) ? 512 + 128 : 0;
  const int total = n_mla_p + n_mla_s + n_cross;
  int hoff = (g == 0) ? 0 : 8;
  const int h0 = (int)(xb_xcc_id() & 7u);
  for (;;) {
    __syncthreads();
    if (threadIdx.x == 0) {
      int item = -1;
      while (hoff < 8) {
        const int hd_ = (h0 + hoff) & 7;
        const unsigned k_ = atomicAdd(qcnt + 8 + hd_, 1u);
        if (k_ < 128u) { item = (int)k_ * 8 + hd_; break; }
        hoff++;
      }
      if (item < 0) item = n_mla_p + (int)atomicAdd(qcnt, 1u);
      *qslot = item;
    }
    __syncthreads();
    const int it = *qslot;
    if (it >= total) break;
    const int w = threadIdx.x >> 6;
    if (it < n_mla_p) {
      const int qt = 127 - (it >> 3), hd = it & 7;
      const int nkt = 2 * qt + 2, nkw = (w < 2) ? 2 * qt + 1 : 2 * qt + 2;
      u16* qb = Q + (long)qt * 128 * 1536 + hd * 192;
      attn_item<192>(qb, 1536, knp + (long)hd * NP * 128, 128, krall, 64, vtp + (long)hd * (NP / 64) * 8192, 64, nkt, nkw, qb, 1536, smem, qt < 64, 8192);
    } else if (it < n_mla_p + n_mla_s) {
      const int j = it - n_mla_p, b = j >> 2, hl = j & 3, hd = 4 * g + hl;
      const long s0 = (long)b * 1088;
      u16* qb = Q + (long)(NP + b * 64) * 1536 + hd * 192;
      attn_item<192>(qb, 1536, kns + ((long)hl * NSKV + s0) * 128, 128, krall + ((long)NP + s0) * 64, 64, vts + ((long)hl * (NSKV / 64) + b * 17) * 8192, 64,
                     17, (w < 2) ? 17 : 0, qb, 1536, smem, false, 8192);
    } else {
      const int j = it - n_mla_p - n_mla_s;
      if (j < 512) {
        const int qt = j >> 2, hx = j & 3;
        u16* qb = xq + (long)qt * 128 * 512 + hx * 128;
        attn_item<128>(qb, 512, memk_p + hx * 128, 512, nullptr, 0, memvT_p + (long)hx * 128 * 256, 256, 4, 4, qb, 512, smem);
      } else {
        const int jj = j - 512, b = jj >> 2, hx = jj & 3;
        u16* qb = xq + (long)(NP + b * 64) * 512 + hx * 128;
        attn_item<128>(qb, 512, memk_s + (long)b * 256 * 512 + hx * 128, 512, nullptr, 0,
                       memvT_s + (long)(b * 4 + hx) * 128 * 256, 256, 4, (w < 2) ? 4 : 0, qb, 512, smem);
      }
    }
  }
}
DI void cross_phase_l1(const Params& p, unsigned* qcnt, char* smem) {
  char* ws = launder(p.ws);
  u16* xq = (u16*)(ws + W_XQ1);
  const u16* memk_p = (const u16*)(ws + W_MEMKP) + 256 * 512;
  const u16* memvT_p = (const u16*)(ws + W_MEMVTP) + 4 * 128 * 256;
  const u16* memk_s = (const u16*)(ws + W_MEMKS1);
  const u16* memvT_s = (const u16*)(ws + W_MEMVTS1);
  volatile int* qslot = (volatile int*)(smem + SMEM_MAIN + 16);
  for (;;) {
    __syncthreads();
    if (threadIdx.x == 0) *qslot = (int)atomicAdd(qcnt, 1u);
    __syncthreads();
    const int j = *qslot;
    if (j >= 640) break;
    const int w = threadIdx.x >> 6;
    if (j < 512) {
      const int qt = j >> 2, hx = j & 3;
      u16* qb = xq + (long)qt * 128 * 512 + hx * 128;
      attn_item<128>(qb, 512, memk_p + hx * 128, 512, nullptr, 0, memvT_p + (long)hx * 128 * 256, 256, 4, 4, qb, 512, smem);
    } else {
      const int jj = j - 512, b = jj >> 2, hx = jj & 3;
      u16* qb = xq + (long)(NP + b * 64) * 512 + hx * 128;
      attn_item<128>(qb, 512, memk_s + (long)b * 256 * 512 + hx * 128, 512, nullptr, 0,
                     memvT_s + (long)(b * 4 + hx) * 128 * 256, 256, 4, (w < 2) ? 4 : 0, qb, 512, smem);
    }
  }
}

DI void hgrn_chunk_item(const Params& p, int n, int hd, char* smem) {
  char* ws = launder(p.ws);
  u16* qs = (u16*)(ws + W_QS);
  float* f = (float*)(ws + W_F);
  const u16* vv = (const u16*)(ws + W_V);
  u16* U = (u16*)(ws + W_U);
  float* decay = (float*)(ws + W_DECAY);
  const float* lbv = (const float*)(ws + W_LBV);
  u16* QS = (u16*)smem;
  u16* KS = QS + 64 * 136;
  u16* KDT = KS + 64 * 136;
  u16* VTs = KDT + 128 * 68;
  float* tot = (float*)(VTs + 128 * 68);
  float* lg32 = tot + 256;
  const int tid = opaque_tid(), lane = tid & 63, w = tid >> 6, h = lane >> 5, r = lane & 31;
  const int d = tid & 127, hf = tid >> 7;
  const long t0 = (n < 256) ? (long)n * 64 : (long)NP + (long)(n - 256) * 64;
  const int col = hd * 128 + d;
  const float lb = lbv[col];
  __syncthreads();
  {
    float run = 0.f;
#pragma unroll 1
    for (int j0 = 0; j0 < 32; j0 += 16) {
      float fv[16];
#pragma unroll
      for (int jj = 0; jj < 16; jj++) fv[jj] = f[(t0 + hf * 32 + j0 + jj) * 1024 + col];
#pragma unroll
      for (int jj = 0; jj < 16; jj++) {
        const float lg = __logf(lb + (1.f - lb) * sigmoidf_(fv[jj]));
        if (j0 + jj == 0 && hf == 1) lg32[d] = lg;
        run += lg;
      }
    }
    tot[hf * 128 + d] = run;
  }
  __syncthreads();
  {
    const float tot0 = tot[d], blast = tot0 + tot[128 + d], ref = tot0 + lg32[d];
    float b = hf ? tot0 : 0.f;
    if (hf == 0) decay[((long)n * 8 + hd) * 128 + d] = __expf(blast);
#pragma unroll 1
    for (int j0 = 0; j0 < 32; j0 += 8) {
      float fv[8]; u16 qv[8], vv8[8];
#pragma unroll
      for (int jj = 0; jj < 8; jj++) {
        const long gi = (t0 + hf * 32 + j0 + jj) * 1024 + col;
        fv[jj] = f[gi]; qv[jj] = qs[gi]; vv8[jj] = vv[gi];
      }
#pragma unroll
      for (int jj = 0; jj < 8; jj++) {
        const int t = hf * 32 + j0 + jj;
        const long gi = (t0 + t) * 1024 + col;
        const float sg = sigmoidf_(fv[jj]);
        b += __logf(lb + (1.f - lb) * sg);
        const float kk = (1.f - lb) * sigmoidf_(-fv[jj]);
        const float q = bf2f(qv[jj]);
        QS[t * 136 + d] = f2bf(q * __expf(b - ref));
        KS[t * 136 + d] = f2bf(kk * __expf(ref - b));
        KDT[d * 68 + t] = f2bf(kk * __expf(blast - b));
        VTs[d * 68 + t] = vv8[jj];
        qs[gi] = f2bf(q * __expf(b));
      }
    }
  }
  __syncthreads();
  {
    const int ntl = w & 1, vh = w >> 1;
    f32x16 at[2];
#pragma unroll
    for (int ms = 0; ms < 2; ms++)
#pragma unroll
      for (int i = 0; i < 16; i++) at[ms][i] = 0.f;
#pragma unroll
    for (int ms = 0; ms < 2; ms++) {
      if (ms <= ntl) {
#pragma unroll
        for (int ks = 0; ks < 8; ks++) {
          const bf16x8 a = *(const bf16x8*)(KS + (ms * 32 + r) * 136 + ks * 16 + h * 8);
          const bf16x8 b = *(const bf16x8*)(QS + (ntl * 32 + r) * 136 + ks * 16 + h * 8);
          at[ms] = MFMA(a, b, at[ms]);
        }
        if (ms == ntl) {
#pragma unroll
          for (int i = 0; i < 16; i++) if (crow(i, h) > r) at[ms][i] = 0.f;
        }
      }
    }
    f32x16 o[2];
#pragma unroll
    for (int mv = 0; mv < 2; mv++)
#pragma unroll
      for (int i = 0; i < 16; i++) o[mv][i] = 0.f;
#pragma unroll
    for (int ms = 0; ms < 2; ms++)
#pragma unroll
      for (int sp = 0; sp < 2; sp++) {
        const int st = 2 * ms + sp;
        unsigned pp[4];
#pragma unroll
        for (int j = 0; j < 4; j++) pp[j] = pack2(at[ms][8 * sp + 2 * j], at[ms][8 * sp + 2 * j + 1]);
        const bf16x8 pf = __builtin_bit_cast(bf16x8, make_uint4(pp[0], pp[1], pp[2], pp[3]));
#pragma unroll
        for (int mv = 0; mv < 2; mv++) {
          const u16* vp = VTs + ((vh * 2 + mv) * 32 + r) * 68 + 16 * st + 4 * h;
          const uint2 lo = *(const uint2*)vp;
          const uint2 hi = *(const uint2*)(vp + 8);
          const bf16x8 vf = __builtin_bit_cast(bf16x8, make_uint4(lo.x, lo.y, hi.x, hi.y));
          o[mv] = MFMA(vf, pf, o[mv]);
        }
      }
    float* op = f + (t0 + ntl * 32 + r) * 1024 + hd * 128;
#pragma unroll
    for (int mv = 0; mv < 2; mv++)
#pragma unroll
      for (int g = 0; g < 4; g++)
        *(float4*)(op + (vh * 2 + mv) * 32 + 8 * g + 4 * h) = make_float4(o[mv][4 * g], o[mv][4 * g + 1], o[mv][4 * g + 2], o[mv][4 * g + 3]);
  }
  {
    f32x16 u[4];
#pragma unroll
    for (int nk = 0; nk < 4; nk++)
#pragma unroll
      for (int i = 0; i < 16; i++) u[nk][i] = 0.f;
#pragma unroll
    for (int ss = 0; ss < 4; ss++) {
      const u16* ap = VTs + (w * 32 + r) * 68 + ss * 16 + h * 8;
      const uint2 alo = *(const uint2*)ap, ahi = *(const uint2*)(ap + 4);
      const bf16x8 a = __builtin_bit_cast(bf16x8, make_uint4(alo.x, alo.y, ahi.x, ahi.y));
#pragma unroll
      for (int nk = 0; nk < 4; nk++) {
        const u16* bp = KDT + (nk * 32 + r) * 68 + ss * 16 + h * 8;
        const uint2 blo = *(const uint2*)bp, bhi = *(const uint2*)(bp + 4);
        const bf16x8 b = __builtin_bit_cast(bf16x8, make_uint4(blo.x, blo.y, bhi.x, bhi.y));
        u[nk] = MFMA(a, b, u[nk]);
      }
    }
    u16* up = U + ((long)n * 8 + hd) * 128 * 128;
#pragma unroll
    for (int nk = 0; nk < 4; nk++)
#pragma unroll
      for (int i = 0; i < 16; i++) up[(w * 32 + crow(i, h)) * 128 + nk * 32 + r] = f2bf(u[nk][i]);
  }
}

DI void hgrn_scan_phase(const Params& p, char* smem) {
  char* ws = launder(p.ws);
  u16* U = (u16*)(ws + W_U);
  const float* decay = (const float*)(ws + W_DECAY);
  const int tid = opaque_tid();
  for (int it = blockIdx.x; it < 512; it += gridDim.x) {
    const int hd = it >> 6, v = (it & 63) * 2 + (tid >> 7), k = tid & 127;
    u16* up = U + ((long)hd * 128 + v) * 128 + k;
    const float* dp = decay + hd * 128 + k;
    float S = 0.f;
    float cu[8], cd[8];
#pragma unroll
    for (int j = 0; j < 8; j++) { cu[j] = bf2f(up[(long)j * 131072]); cd[j] = dp[j * 1024]; }
    for (int n0 = 0; n0 < 256; n0 += 8) {
      float nu[8], nd[8];
      if (n0 + 8 < 256) {
#pragma unroll
        for (int j = 0; j < 8; j++) { nu[j] = bf2f(up[(long)(n0 + 8 + j) * 131072]); nd[j] = dp[(n0 + 8 + j) * 1024]; }
      } else {
#pragma unroll
        for (int j = 0; j < 8; j++) { nu[j] = 0.f; nd[j] = 0.f; }
      }
#pragma unroll
      for (int j = 0; j < 8; j++) { up[(long)(n0 + j) * 131072] = f2bf(S); S = cd[j] * S + cu[j]; }
#pragma unroll
      for (int j = 0; j < 8; j++) { cu[j] = nu[j]; cd[j] = nd[j]; }
    }
    p.out[O_HGP + ((long)hd * 128 + k) * 128 + v] = S;
  }
  float* t1 = (float*)smem;
  float* t2 = t1 + 32 * 33;
  for (int it = blockIdx.x; it < 4096; it += gridDim.x) {
    const int bh = it >> 4, kt = (it >> 2) & 3, vt = it & 3, b = bh >> 3, hd = bh & 7;
    const float* s0 = p.in[I_CHS] + (long)bh * 16384;
    float* so = p.out + O_HGS + (long)bh * 16384;
    const int n = 256 + b;
    u16* up = U + ((long)n * 8 + hd) * 16384;
    const float* dp = decay + ((long)n * 8 + hd) * 128;
    const int c = tid & 31, r0 = tid >> 5;
    __syncthreads();
#pragma unroll
    for (int j = 0; j < 4; j++) { const int rr = r0 + 8 * j; t1[rr * 33 + c] = s0[(kt * 32 + rr) * 128 + vt * 32 + c]; }
    __syncthreads();
#pragma unroll
    for (int j = 0; j < 4; j++) {
      const int vl = r0 + 8 * j, kl = c;
      const float sv = t1[kl * 33 + vl];
      const long ui = (long)(vt * 32 + vl) * 128 + kt * 32 + kl;
      const float uv = bf2f(up[ui]);
      up[ui] = f2bf(sv);
      t2[kl * 33 + vl] = dp[kt * 32 + kl] * sv + uv;
    }
    __syncthreads();
#pragma unroll
    for (int j = 0; j < 4; j++) { const int rr = r0 + 8 * j; so[(kt * 32 + rr) * 128 + vt * 32 + c] = t2[rr * 33 + c]; }
  }
}

DI void hgrn_final_item(const Params& p, int n, int hd, char* smem) {
  char* ws = launder(p.ws);
  u16* qb = (u16*)(ws + W_QS);
  const float* oi = (const float*)(ws + W_F);
  const u16* gs = (const u16*)(ws + W_GS);
  const u16* U = (const u16*)(ws + W_U);
  const float* gon = p.in[I_ONORM];
  u16* Ss = (u16*)smem;
  u16* Qb = Ss + 128 * 136;
  float* T = (float*)smem;
  const int tid = opaque_tid(), lane = tid & 63, w = tid >> 6, h = lane >> 5, r = lane & 31;
  const int ntl = w & 1, vh = w >> 1;
  const long t0 = (n < 256) ? (long)n * 64 : (long)NP + (long)(n - 256) * 64;
  const u16* sp = U + ((long)n * 8 + hd) * 16384;
  __syncthreads();
  {
    uint4 sv[8], qv[4];
    const int row = tid >> 4, ch = tid & 15;
#pragma unroll
    for (int j = 0; j < 8; j++) sv[j] = *(const uint4*)(sp + (row + 16 * j) * 128 + ch * 8);
#pragma unroll
    for (int j = 0; j < 4; j++) qv[j] = *(const uint4*)(qb + (t0 + row + 16 * j) * 1024 + hd * 128 + ch * 8);
#pragma unroll
    for (int j = 0; j < 8; j++) *(uint4*)(Ss + (row + 16 * j) * 136 + ch * 8) = sv[j];
#pragma unroll
    for (int j = 0; j < 4; j++) *(uint4*)(Qb + (row + 16 * j) * 136 + ch * 8) = qv[j];
  }
  __syncthreads();
  f32x16 o[2];
#pragma unroll
  for (int mv = 0; mv < 2; mv++)
#pragma unroll
    for (int i = 0; i < 16; i++) o[mv][i] = 0.f;
#pragma unroll
  for (int ks = 0; ks < 8; ks++) {
    const bf16x8 b = *(const bf16x8*)(Qb + (ntl * 32 + r) * 136 + ks * 16 + h * 8);
#pragma unroll
    for (int mv = 0; mv < 2; mv++) {
      const bf16x8 a = *(const bf16x8*)(Ss + ((vh * 2 + mv) * 32 + r) * 136 + ks * 16 + h * 8);
      o[mv] = MFMA(a, b, o[mv]);
    }
  }
  __syncthreads();
#pragma unroll
  for (int mv = 0; mv < 2; mv++)
#pragma unroll
    for (int g = 0; g < 4; g++)
      *(float4*)(T + (ntl * 32 + r) * 132 + (vh * 2 + mv) * 32 + 8 * g + 4 * h) = make_float4(o[mv][4 * g], o[mv][4 * g + 1], o[mv][4 * g + 2], o[mv][4 * g + 3]);
  __syncthreads();
  {
    const int t = tid >> 2, c0 = (tid & 3) * 32;
    const long grow = (t0 + t) * 1024 + hd * 128 + c0;
    float x[32];
    float ss = 0.f;
#pragma unroll
    for (int j = 0; j < 8; j++) {
      const float4 tv = *(const float4*)(T + t * 132 + c0 + 4 * j);
      const float4 ov = ld_nt4(oi + grow + 4 * j);
      x[4 * j] = tv.x + ov.x; x[4 * j + 1] = tv.y + ov.y; x[4 * j + 2] = tv.z + ov.z; x[4 * j + 3] = tv.w + ov.w;
      ss += x[4 * j] * x[4 * j] + x[4 * j + 1] * x[4 * j + 1] + x[4 * j + 2] * x[4 * j + 2] + x[4 * j + 3] * x[4 * j + 3];
    }
    ss += __shfl_xor(ss, 1);
    ss += __shfl_xor(ss, 2);
    const float rsn = rsqrtf(ss * (1.f / 128.f) + EPS);
#pragma unroll
    for (int j = 0; j < 4; j++) {
      const uint4 gg = ld_nt4u(gs + grow + 8 * j);
      const float4 ga = *(const float4*)(gon + c0 + 8 * j), gb = *(const float4*)(gon + c0 + 8 * j + 4);
      uint4 ov;
      ov.x = pack2(x[8 * j] * rsn * ga.x * bf2f((u16)(gg.x & 0xffff)), x[8 * j + 1] * rsn * ga.y * bf2f((u16)(gg.x >> 16)));
      ov.y = pack2(x[8 * j + 2] * rsn * ga.z * bf2f((u16)(gg.y & 0xffff)), x[8 * j + 3] * rsn * ga.w * bf2f((u16)(gg.y >> 16)));
      ov.z = pack2(x[8 * j + 4] * rsn * gb.x * bf2f((u16)(gg.z & 0xffff)), x[8 * j + 5] * rsn * gb.y * bf2f((u16)(gg.z >> 16)));
      ov.w = pack2(x[8 * j + 6] * rsn * gb.z * bf2f((u16)(gg.w & 0xffff)), x[8 * j + 7] * rsn * gb.w * bf2f((u16)(gg.w >> 16)));
      *(uint4*)(qb + grow + 8 * j) = ov;
    }
  }
}

template <class AL, class BL, class EP>
DI void gemm_phase(int MT, int NTL, int K, AL al, BL bl, EP ep, char* smem) {
  for (int t = blockIdx.x; t < MT * NTL; t += gridDim.x) {
    const int tm = t % MT, tn = t / MT;
    f32x16 acc[2][2];
    gemm_core(al, bl, tm * 128, tn * 128, K, smem, acc);
    ep(acc, tm * 128, tn * 128);
  }
}

template <class AL, class BL>
DI void gemm_phase_n1024(int K, AL al, BL bl, u16* Y, u16* parts, char* smem) {
  for (int u = blockIdx.x; u < 1024 + 512; u += gridDim.x) {
    f32x16 acc[2][2];
    if (u < 1024) {
      const int tm = u % 144, tn = u / 144;
      gemm_core(al, bl, tm * 128, tn * 128, K, smem, acc);
      epi_bf16_tile(acc, tm * 128, tn * 128, Y + (long)tm * 128 * 1024 + tn * 128, 1024, smem, [=](int m, int n, float v) { return v; });
    } else {
      const int v = u - 1024, t = 1024 + (v >> 2), q = v & 3, tm = t % 144, tn = t / 144;
      const int koff = q * (K / 4);
      gemm_core([=](int m, int k) { return al(m, k + koff); }, [=](int n, int k) { return bl(n, k + koff); },
                tm * 128, tn * 128, K / 4, smem, acc);
      if (q == 0) epi_bf16_tile(acc, tm * 128, tn * 128, Y + (long)tm * 128 * 1024 + tn * 128, 1024, smem, [=](int m, int n, float vv) { return vv; });
      else epi_bf16_tile(acc, tm * 128, tn * 128, parts + (long)(q - 1) * NT * 128 + (long)tm * 128 * 128, 128, smem, [=](int m, int n, float vv) { return vv; });
    }
  }
}
DI void ffn_up_phase(const Params& p, const u16* xb, int ldx, const u16* wupT, u16* hid, char* smem) {
  const float* rs = (const float*)(p.ws + W_RS);
  gemm_phase(NT / 128, 32, 1024,
             [=](int m, int k) { return xb + (long)m * ldx + k; },
             [=](int n, int k) { return wupT + (long)n * 1024 + k; },
             [=](const f32x16 (&acc)[2][2], int m0, int n0) {
               epi_bf16_tile(acc, m0, n0, hid + (long)m0 * 4096 + n0, 4096, smem, [=](int m, int n, float v) {
                 const float a = fmaxf(v * rs[m], 0.f);
                 return a * a;
               });
             }, smem);
}
DI void ffn_down_phase(const u16* hid, const u16* wdownT, u16* Y, u16* parts, char* smem) {
  gemm_phase_n1024(4096,
                   [=](int m, int k) { return hid + (long)m * 4096 + k; },
                   [=](int n, int k) { return wdownT + (long)n * 4096 + k; }, Y, parts, smem);
}

__global__ void __launch_bounds__(256, 2) fwd_megakernel(Params p) {
  __shared__ __attribute__((aligned(16))) char smem[SMEM_TOTAL];
  unsigned* bar = (unsigned*)launder(p.ws);
  unsigned* qcnt = (unsigned*)(launder(p.ws) + W_QCNT);
  if (threadIdx.x < 4) ((volatile unsigned*)(smem + SMEM_MAIN))[threadIdx.x] = 0u;
  __syncthreads();
  (void)xcd_barrier_post(bar, (volatile LAS unsigned*)(smem + SMEM_MAIN));
#define GRID_BARRIER() do { XcdBarrier b_; b_.bar = (unsigned*)p.ws; b_.x = xb_xcc_id(); b_.st = (volatile LAS unsigned*)(smem + SMEM_MAIN); xcd_barrier(b_); } while (0)

  convert_weight(p.in[I_WIN0], 1024, 1216, 1280, p.in[I_LMPRE], (u16*)(launder(p.ws) + W_IN0T), smem);
  convert_weight(p.in[I_WUQ], 384, 1536, 1536, p.in[I_QNORM], (u16*)(launder(p.ws) + W_UQT), smem, 320);
  convert_weight(p.in[I_WUK], 256, 1024, 1024, nullptr, (u16*)(launder(p.ws) + W_UKT), smem, 464);
  convert_weight(p.in[I_WUV], 256, 1024, 1024, nullptr, (u16*)(launder(p.ws) + W_UVT), smem, 16);
  convert_weight(p.in[I_WOUT0], 1536, 1024, 1024, nullptr, (u16*)(launder(p.ws) + W_OUT0T), smem, 80);
  convert_weight(p.in[I_WMEMKV], 1024, 1024, 1024, p.in[I_MEMNORM], (u16*)(launder(p.ws) + W_MEMT), smem, 464);
  convert_weight(p.in[I_WMEMKV] + 1024 * 1024, 1024, 1024, 1024, p.in[I_MEMNORM] + 1024, (u16*)(launder(p.ws) + W_MEMT) + 1024 * 1024, smem, 208);
  convert_mem_cache(p, 0, (u16*)(launder(p.ws) + W_MEMKS0), (u16*)(launder(p.ws) + W_MEMVTS0), smem);
  {
    const int tid = opaque_tid(), lane = tid & 63, wv = tid >> 6;
    float* ct = (float*)(launder(p.ws) + W_ROPE);
    float* st = ct + 16384 * 32;
    for (long i = (long)blockIdx.x * 256 + tid; i < 16384L * 32; i += (long)gridDim.x * 256) {
      const int pos = (int)(i >> 5), j = (int)(i & 31);
      const double ang = (double)pos * p.inv_freq[j];
      const double k = rint(ang * 0.15915494309189535);
      const float rr = (float)(ang - k * 6.283185307179586);
      ct[i] = cosf(rr); st[i] = sinf(rr);
    }
    float* rs = (float*)(launder(p.ws) + W_RS);
    float* rsmem = (float*)(launder(p.ws) + W_RSMEM);
    float* y = p.out + O_Y;
    u16* xb0 = (u16*)(launder(p.ws) + W_XB0);
    for (int t = blockIdx.x * 4 + wv; t < NT; t += gridDim.x * 4) {
      const float* xr = xrow(p, t);
      float ss = 0.f;
#pragma unroll
      for (int j = 0; j < 4; j++) {
        const float4 v = ld_nt4(xr + j * 256 + lane * 4);
        ss += v.x * v.x + v.y * v.y + v.z * v.z + v.w * v.w;
        uint2 o; o.x = pack2(v.x, v.y); o.y = pack2(v.z, v.w);
        *(uint2*)(xb0 + (long)t * 1024 + j * 256 + lane * 4) = o;
      }
      ss = wave_sum(ss);
      if (lane == 0) rs[t] = rsqrtf(ss * (1.f / 1024.f) + EPS);
    }
    u16* memb = (u16*)(launder(p.ws) + W_MEMB);
    for (int t = blockIdx.x * 4 + wv; t < 256; t += gridDim.x * 4) {
      const float* xr = p.in[I_MEMP] + (long)t * 1024;
      float ss = 0.f;
#pragma unroll
      for (int j = 0; j < 4; j++) {
        const float4 v = ld_nt4(xr + j * 256 + lane * 4);
        ss += v.x * v.x + v.y * v.y + v.z * v.z + v.w * v.w;
        uint2 o; o.x = pack2(v.x, v.y); o.y = pack2(v.z, v.w);
        *(uint2*)(memb + (long)t * 1024 + j * 256 + lane * 4) = o;
      }
      ss = wave_sum(ss);
      if (lane == 0) rsmem[t] = rsqrtf(ss * (1.f / 1024.f) + EPS);
    }
    u16* latall = (u16*)(launder(p.ws) + W_LATALL);
    u16* krall = (u16*)(launder(p.ws) + W_KRALL);
    for (long i = (long)blockIdx.x * 256 + tid; i < 32L * 1024 * 64; i += (long)gridDim.x * 256) {
      const long row = i >> 6; const int c4 = (int)(i & 63);
      const int b = (int)(row >> 10), j = (int)(row & 1023);
      const float4 v = ld_nt4(p.in[I_CLAT] + row * 256 + c4 * 4);
      uint2 o; o.x = pack2(v.x, v.y); o.y = pack2(v.z, v.w);
      *(uint2*)(latall + ((long)NP + b * 1088 + j) * 256 + c4 * 4) = o;
    }
    for (long i = (long)blockIdx.x * 256 + tid; i < 32L * 1024 * 16; i += (long)gridDim.x * 256) {
      const long row = i >> 4; const int c4 = (int)(i & 15);
      const int b = (int)(row >> 10), j = (int)(row & 1023);
      const float4 v = ld_nt4(p.in[I_CKR] + row * 64 + c4 * 4);
      uint2 o; o.x = pack2(v.x, v.y); o.y = pack2(v.z, v.w);
      *(uint2*)(krall + ((long)NP + b * 1088 + j) * 64 + c4 * 4) = o;
    }
    float* lbv = (float*)(launder(p.ws) + W_LBV);
    for (int i = blockIdx.x * 256 + tid; i < 1024; i += gridDim.x * 256)
      lbv[i] = 1.f / (1.f + expf(p.in[I_LB][i] - p.in[I_LB][1024 + i]));
  }
  if (p.never) cg::this_grid().sync();
  GRID_BARRIER();

  {
    const u16* memb = (const u16*)(launder(p.ws) + W_MEMB);
    const u16* wmemT = (const u16*)(launder(p.ws) + W_MEMT);
    const u16* xb0 = (const u16*)(launder(p.ws) + W_XB0);
    const u16* win0T = (const u16*)(launder(p.ws) + W_IN0T);
    u16* P0b = (u16*)(launder(p.ws) + W_P0F);
    u16* memk_p = (u16*)(launder(p.ws) + W_MEMKP);
    u16* memvT_p = (u16*)(launder(p.ws) + W_MEMVTP);
    float* out = p.out;
    const float* rs = (const float*)(launder(p.ws) + W_RS);
    const float* rsmem = (const float*)(launder(p.ws) + W_RSMEM);
    const int n_mem = 2 * 2 * 8, n_proj = (NT / 128) * 10;
    for (int t = blockIdx.x; t < n_mem + n_proj; t += gridDim.x) {
      f32x16 acc[2][2];
      if (t < n_mem) {
        const int l = t >> 4, tm = (t >> 3) & 1, tn = t & 7;
        const u16* wl = wmemT + (long)l * 1024 * 1024;
        gemm_core([=](int m, int k) { return memb + (long)m * 1024 + k; },
                  [=](int n, int k) { return wl + (long)n * 1024 + k; }, tm * 128, tn * 128, 1024, smem, acc);
        epi_each(acc, tm * 128, tn * 128, [=](int m, int n, float v) {
          v *= rsmem[m];
          if (n < 512) {
            out[O_MKP + ((long)l * 256 + m) * 512 + n] = v;
            memk_p[((long)l * 256 + m) * 512 + n] = f2bf(v);
          } else {
            const int e = n - 512;
            out[O_MVP + ((long)l * 256 + m) * 512 + e] = v;
            memvT_p[((long)l * 512 + e) * 256 + m] = f2bf(v);
          }
        });
      } else {
        const int tt = t - n_mem, tm = tt % (NT / 128), tn = tt / (NT / 128);
        gemm_core([=](int m, int k) { return xb0 + (long)m * 1024 + k; },
                  [=](int n, int k) { return win0T + (long)n * 1024 + k; }, tm * 128, tn * 128, 1024, smem, acc);
        epi_bf16_tile(acc, tm * 128, tn * 128, P0b + (long)tm * 128 * 1280 + tn * 128, 1280, smem, [=](int m, int n, float v) { return v * rs[m]; });
      }
    }
  }
  GRID_BARRIER();

  {
    const u16* P0b = (const u16*)(launder(p.ws) + W_P0F);
    const float* ct = (const float*)(launder(p.ws) + W_ROPE);
    const float* st = ct + 16384 * 32;
    u16* cqn = (u16*)(launder(p.ws) + W_CQN);
    u16* xq = (u16*)(launder(p.ws) + W_XQ0);
    u16* latall = (u16*)(launder(p.ws) + W_LATALL);
    u16* krall = (u16*)(launder(p.ws) + W_KRALL);
    const float* gkv = p.in[I_KVNORM];
    const int tid = opaque_tid(), lane = tid & 63, wv = tid >> 6;
    for (int t = blockIdx.x * 4 + wv; t < NT; t += gridDim.x * 4) {
      const u16* pr = P0b + (long)t * 1280;
      const int pos = tok_pos(t);
      const long kv = tok_kv(t);
      float* lat_o = (t < NP) ? p.out + O_LATP + (long)t * 256 : p.out + O_LATS + (long)(t - NP) * 256;
      float* kr_o = (t < NP) ? p.out + O_KRP + (long)t * 64 : p.out + O_KRS + (long)(t - NP) * 64;
      float cq[6]; float ss = 0.f;
#pragma unroll
      for (int j = 0; j < 6; j++) { cq[j] = bf2f(pr[j * 64 + lane]); ss += cq[j] * cq[j]; }
      ss = wave_sum(ss);
      float r = rsqrtf(ss * (1.f / 384.f) + EPS);
#pragma unroll
      for (int j = 0; j < 6; j++) cqn[(long)t * 384 + j * 64 + lane] = f2bf(cq[j] * r);
      float ck[4]; ss = 0.f;
#pragma unroll
      for (int j = 0; j < 4; j++) { ck[j] = bf2f(pr[384 + j * 64 + lane]); ss += ck[j] * ck[j]; }
      ss = wave_sum(ss);
      r = rsqrtf(ss * (1.f / 256.f) + EPS);
#pragma unroll
      for (int j = 0; j < 4; j++) {
        const float v = ck[j] * r * gkv[j * 64 + lane];
        lat_o[j * 64 + lane] = v;
        latall[kv * 256 + j * 64 + lane] = f2bf(v);
      }
      {
        const float xv = bf2f(pr[640 + lane]);
        const float pv = __shfl_xor(xv, 32);
        const int i = lane & 31;
        const float c = ct[pos * 32 + i], s = st[pos * 32 + i];
        const float v = (lane < 32) ? xv * c - pv * s : xv * c + pv * s;
        kr_o[lane] = v;
        krall[kv * 64 + lane] = f2bf(v);
      }
#pragma unroll
      for (int j = 0; j < 8; j++) xq[(long)t * 512 + j * 64 + lane] = f2bf(bf2f(pr[704 + j * 64 + lane]) * XSCALE);
    }
  }
  GRID_BARRIER();

  for (int g = 0; g < 2; g++) {
    {
      const u16* cqn = (const u16*)(launder(p.ws) + W_CQN);
      const u16* wuqT = (const u16*)(launder(p.ws) + W_UQT);
      const u16* latall = (const u16*)(launder(p.ws) + W_LATALL);
      const u16* lats = latall + (long)NP * 256;
      const u16* wukT = (const u16*)(launder(p.ws) + W_UKT);
      const u16* wuvT = (const u16*)(launder(p.ws) + W_UVT);
      const u16* wukTg = wukT + (long)g * 512 * 256;
      const u16* wuvTg = wuvT + (long)g * 512 * 256;
      const float* ct = (const float*)(launder(p.ws) + W_ROPE);
      const float* st = ct + 16384 * 32;
      u16* Q = (u16*)(launder(p.ws) + W_Q);
      u16* knp = (u16*)(launder(p.ws) + W_KNP);
      u16* vtp = (u16*)(launder(p.ws) + W_VTP);
      u16* kns = (u16*)(launder(p.ws) + W_KNS);
      u16* vts = (u16*)(launder(p.ws) + W_VTS);
      const int n_q = (g == 0) ? (NT / 128) * 12 : 0;
      const int n_kp = (g == 0) ? (NP / 128) * 8 : 0, n_vp = n_kp;
      const int n_ks = (NSKV / 128) * 4, n_vs = n_ks;
      const int e1 = n_q, e2 = e1 + n_kp, e3 = e2 + n_vp, e4 = e3 + n_ks, e5 = e4 + n_vs;
      for (int t = blockIdx.x; t < e5; t += gridDim.x) {
        f32x16 acc[2][2];
        if (t < e1) {
          const int tm = t % (NT / 128), tn = t / (NT / 128), m0 = tm * 128, n0 = tn * 128;
          gemm_core([=](int m, int k) { return cqn + (long)m * 384 + k; },
                    [=](int n, int k) { return wuqT + (long)n * 384 + k; }, m0, n0, 384, smem, acc);
          const int tid = opaque_tid(), lane = tid & 63, wv = tid >> 6;
          const int wm = wv >> 1, wn = wv & 1, h = lane >> 5, r = lane & 31;
          const int nw0 = n0 + wn * 64;
          const bool is_rope = (nw0 % 192) == 128;
          if (is_rope) {
#pragma unroll
            for (int mt = 0; mt < 2; mt++)
#pragma unroll
              for (int i = 0; i < 16; i++) {
                const int m = m0 + wm * 64 + mt * 32 + crow(i, h);
                const float v0 = acc[mt][0][i], v1 = acc[mt][1][i];
                const int pos = tok_pos(m);
                const float c = ct[pos * 32 + r], s = st[pos * 32 + r];
                Q[(long)m * 1536 + nw0 + r] = f2bf((v0 * c - v1 * s) * QSCALE);
                Q[(long)m * 1536 + nw0 + 32 + r] = f2bf((v1 * c + v0 * s) * QSCALE);
              }
          } else {
#pragma unroll
            for (int mt = 0; mt < 2; mt++)
#pragma unroll
              for (int i = 0; i < 16; i++) {
                const int m = m0 + wm * 64 + mt * 32 + crow(i, h);
                Q[(long)m * 1536 + nw0 + r] = f2bf(acc[mt][0][i] * QSCALE);
                Q[(long)m * 1536 + nw0 + 32 + r] = f2bf(acc[mt][1][i] * QSCALE);
              }
          }
        } else if (t < e2) {
          const int tt = t - e1, tm = tt % (NP / 128), tn = tt / (NP / 128);
          gemm_core([=](int m, int k) { return latall + (long)m * 256 + k; },
                    [=](int n, int k) { return wukT + (long)n * 256 + k; }, tm * 128, tn * 128, 256, smem, acc);
          epi_bf16_tile(acc, tm * 128, tn * 128, knp + ((long)tn * NP + tm * 128) * 128, 128, smem, [=](int m, int n, float v) { return v; });
        } else if (t < e3) {
          const int tt = t - e2, tn = tt % (NP / 128), tm = tt / (NP / 128);
          gemm_core([=](int m, int k) { return wuvT + (long)m * 256 + k; },
                    [=](int n, int k) { return latall + (long)n * 256 + k; }, tm * 128, tn * 128, 256, smem, acc);
          epi_bf16_vtile(acc, vtp + ((long)tm * (NP / 64) + 2 * tn) * 8192, smem, [=](float v) { return v; });
        } else if (t < e4) {
          const int tt = t - e3, tm = tt % (NSKV / 128), tn = tt / (NSKV / 128);
          gemm_core([=](int m, int k) { return lats + (long)m * 256 + k; },
                    [=](int n, int k) { return wukTg + (long)n * 256 + k; }, tm * 128, tn * 128, 256, smem, acc);
          epi_bf16_tile(acc, tm * 128, tn * 128, kns + ((long)tn * NSKV + tm * 128) * 128, 128, smem, [=](int m, int n, float v) { return v; });
        } else {
          const int tt = t - e4, tn = tt % (NSKV / 128), tm = tt / (NSKV / 128);
          gemm_core([=](int m, int k) { return wuvTg + (long)m * 256 + k; },
                    [=](int n, int k) { return lats + (long)n * 256 + k; }, tm * 128, tn * 128, 256, smem, acc);
          epi_bf16_vtile(acc, vts + ((long)tm * (NSKV / 64) + 2 * tn) * 8192, smem, [=](float v) { return v; });
        }
      }
    }
    GRID_BARRIER();
    attn_phase_l0(p, g, qcnt + g, smem);
    GRID_BARRIER();
  }

  {
    const u16* Q = (const u16*)(launder(p.ws) + W_Q);
    const u16* xq = (const u16*)(launder(p.ws) + W_XQ0);
    const u16* woutT = (const u16*)(launder(p.ws) + W_OUT0T);
    u16* Y = (u16*)(launder(p.ws) + W_Y7);
    gemm_phase_n1024(1536,
               [=](int m, int k) { return (k < 1024) ? Q + (long)m * 1536 + (k >> 7) * 192 + (k & 127) : xq + (long)m * 512 + (k - 1024); },
               [=](int n, int k) { return woutT + (long)n * 1536 + k; }, Y, (u16*)(launder(p.ws) + W_PART7), smem);
  }
  GRID_BARRIER();
  rowwise_residual(p, (const u16*)(launder(p.ws) + W_Y7), p.in[I_LMPOST], 0, (const u16*)(launder(p.ws) + W_PART7));
  convert_weight(p.in[I_WUP], 1024, 4096, 4096, p.in[I_LFPRE], (u16*)(launder(p.ws) + W_UP0T), smem);
  convert_weight(p.in[I_WDOWN], 4096, 1024, 1024, nullptr, (u16*)(launder(p.ws) + W_DOWN0T), smem);
  GRID_BARRIER();
  ffn_up_phase(p, xres_base(p), XR_LD, (const u16*)(launder(p.ws) + W_UP0T), (u16*)(launder(p.ws) + W_HID0), smem);
  GRID_BARRIER();
  ffn_down_phase((const u16*)(launder(p.ws) + W_HID0), (const u16*)(launder(p.ws) + W_DOWN0T), (u16*)(launder(p.ws) + W_Y10), (u16*)(launder(p.ws) + W_PART10), smem);
  GRID_BARRIER();
  rowwise_residual(p, (const u16*)(launder(p.ws) + W_Y10), p.in[I_LFPOST], 1, (const u16*)(launder(p.ws) + W_PART10));
  convert_weight(p.in[I_WIN1], 1024, 4608, 4608, p.in[I_LMPRE] + 1024, (u16*)(launder(p.ws) + W_IN1T), smem);
  convert_weight(p.in[I_WOUT1], 1536, 1024, 1024, nullptr, (u16*)(launder(p.ws) + W_OUT1T), smem, 128);
  GRID_BARRIER();
  {
    const u16* xb1 = xres_base(p);
    const u16* win1T = (const u16*)(launder(p.ws) + W_IN1T);
    u16* qs = (u16*)(launder(p.ws) + W_QS);
    float* f = (float*)(launder(p.ws) + W_F);
    u16* vv = (u16*)(launder(p.ws) + W_V);
    u16* gs = (u16*)(launder(p.ws) + W_GS);
    u16* xq1 = (u16*)(launder(p.ws) + W_XQ1);
    const float* rs = (const float*)(launder(p.ws) + W_RS);
    gemm_phase(NT / 128, 36, 1024,
               [=](int m, int k) { return xb1 + (long)m * XR_LD + k; },
               [=](int n, int k) { return win1T + (long)n * 1024 + k; },
               [=](const f32x16 (&acc)[2][2], int m0, int n0) {
                 const int cb = n0 >> 10;
                 if (cb == 0) epi_bf16_tile(acc, m0, n0, qs + (long)m0 * 1024 + n0, 1024, smem, [=](int m, int n, float v) { return siluf_(v * rs[m]); });
                 else if (cb == 1) epi_each(acc, m0, n0, [=](int m, int n, float v) { f[(long)m * 1024 + (n - 1024)] = v * rs[m]; });
                 else if (cb == 2) epi_bf16_tile(acc, m0, n0, vv + (long)m0 * 1024 + (n0 - 2048), 1024, smem, [=](int m, int n, float v) { return v * rs[m]; });
                 else if (cb == 3) epi_bf16_tile(acc, m0, n0, gs + (long)m0 * 1024 + (n0 - 3072), 1024, smem, [=](int m, int n, float v) { return siluf_(v * rs[m]); });
                 else epi_bf16_tile(acc, m0, n0, xq1 + (long)m0 * 512 + (n0 - 4096), 512, smem, [=](int m, int n, float v) { return v * rs[m] * XSCALE; });
               }, smem);
  }
  GRID_BARRIER();
  for (int it = blockIdx.x; it < NCHUNK * 8; it += gridDim.x) hgrn_chunk_item(p, it >> 3, it & 7, smem);
  GRID_BARRIER();
  hgrn_scan_phase(p, smem);
  __syncthreads();
  convert_mem_cache(p, 1, (u16*)(launder(p.ws) + W_MEMKS1), (u16*)(launder(p.ws) + W_MEMVTS1), smem);
  GRID_BARRIER();
  for (int it = blockIdx.x; it < NCHUNK * 8; it += gridDim.x) hgrn_final_item(p, it >> 3, it & 7, smem);
  cross_phase_l1(p, qcnt + 2, smem);
  GRID_BARRIER();
  {
    const u16* mix = (const u16*)(launder(p.ws) + W_QS);
    const u16* xq1 = (const u16*)(launder(p.ws) + W_XQ1);
    const u16* woutT = (const u16*)(launder(p.ws) + W_OUT1T);
    u16* Y = (u16*)(launder(p.ws) + W_Y16);
    gemm_phase_n1024(1536,
               [=](int m, int k) { return (k < 1024) ? mix + (long)m * 1024 + k : xq1 + (long)m * 512 + (k - 1024); },
               [=](int n, int k) { return woutT + (long)n * 1536 + k; }, Y, (u16*)(launder(p.ws) + W_PART16), smem);
  }
  GRID_BARRIER();
  rowwise_residual(p, (const u16*)(launder(p.ws) + W_Y16), p.in[I_LMPOST] + 1024, 1, (const u16*)(launder(p.ws) + W_PART16));
  convert_weight(p.in[I_WUP] + 1024L * 4096, 1024, 4096, 4096, p.in[I_LFPRE] + 1024, (u16*)(launder(p.ws) + W_UP1T), smem);
  convert_weight(p.in[I_WDOWN] + 4096L * 1024, 4096, 1024, 1024, nullptr, (u16*)(launder(p.ws) + W_DOWN1T), smem);
  GRID_BARRIER();
  ffn_up_phase(p, xres_base(p), XR_LD, (const u16*)(launder(p.ws) + W_UP1T), (u16*)(launder(p.ws) + W_HID1), smem);
  GRID_BARRIER();
  ffn_down_phase((const u16*)(launder(p.ws) + W_HID1), (const u16*)(launder(p.ws) + W_DOWN1T), (u16*)(launder(p.ws) + W_Y19), (u16*)(launder(p.ws) + W_PART19), smem);
  GRID_BARRIER();
  rowwise_residual(p, (const u16*)(launder(p.ws) + W_Y19), p.in[I_LFPOST] + 1024, 2, (const u16*)(launder(p.ws) + W_PART19));
}

extern "C" void kernel_launch(void* const* d_in, const int* in_sizes, int n_in, void* d_out, int out_size,
                              void* d_ws, size_t ws_size, hipStream_t stream) {
  static int grid_blocks = 0;
  if (!grid_blocks) {
    int dev = 0, cus = 0, per_cu = 0;
    (void)hipGetDevice(&dev);
    (void)hipDeviceGetAttribute(&cus, hipDeviceAttributeMultiprocessorCount, dev);
    (void)hipOccupancyMaxActiveBlocksPerMultiprocessor(&per_cu, fwd_megakernel, 256, 0);
    if (per_cu > 2) per_cu = 2;
    if (per_cu < 1) per_cu = 1;
    grid_blocks = cus * per_cu;
  }
  if (ws_size < WS_NEED || n_in < 27) { fprintf(stderr, "workspace too small: %zu < %zu\n", ws_size, WS_NEED); return; }
  Params p;
  memset(&p, 0, sizeof(p));
  for (int i = 0; i < 27; i++) p.in[i] = (const float*)d_in[i];
  p.out = (float*)d_out;
  p.ws = (char*)d_ws;
  for (int i = 0; i < 32; i++) p.inv_freq[i] = pow(10000.0, -(double)i / 32.0);
  p.never = 0;
  (void)hipMemsetAsync(d_ws, 0, 65536, stream);
  void* args[] = {&p};
  hipError_t e = hipLaunchCooperativeKernel((void*)fwd_megakernel, dim3(grid_blocks), dim3(256), args, 0, stream);
  if (e != hipSuccess) fprintf(stderr, "cooperative launch failed: %s (grid %d)\n", hipGetErrorString(e), grid_blocks);
}
```

```cpp
#include <hip/hip_runtime.h>
#include <hip/hip_cooperative_groups.h>
#include <stdint.h>
#include <math.h>
#include <stdio.h>
#include <string.h>
namespace cg = cooperative_groups;

#define DI __device__ __forceinline__
typedef unsigned short u16;
typedef __attribute__((ext_vector_type(8))) short bf16x8;
typedef __attribute__((ext_vector_type(4))) short s16x4;
typedef __attribute__((ext_vector_type(16))) float f32x16;
#define MFMA(a, b, c) __builtin_amdgcn_mfma_f32_32x32x16_bf16((a), (b), (c), 0, 0, 0)

constexpr int NP = 16384, NS = 2048, NT = NP + NS, NKV = NP + 32 * 1088;
constexpr int NCHUNK = NT / 64;
constexpr float EPS = 1e-6f;
constexpr float LOG2E = 1.4426950408889634f;
constexpr float QSCALE = 0.07216878364870322f * LOG2E;
constexpr float XSCALE = 0.08838834764831845f * LOG2E;

constexpr long O_Y = 0, O_LATP = 18874368, O_KRP = 23068672, O_HGP = 24117248, O_MKP = 24248320,
               O_MVP = 24510464, O_LATS = 24772608, O_KRS = 25296896, O_HGS = 25427968;

constexpr size_t MiB = 1048576;
constexpr size_t WS_NEED = 304 * MiB;
constexpr size_t W_QCNT = 16384;
constexpr size_t W_RS = 0x10000, W_RSMEM = 0x30000, W_LBV = 0x31000, W_DECAY = 0x40000;
constexpr size_t W_MEMKP = 3 * MiB, W_MEMVTP = 3 * MiB + MiB / 2;
constexpr size_t W_IN0T = 4 * MiB, W_UQT = 6 * MiB + MiB / 2, W_UKT = 7 * MiB + 3 * MiB / 4, W_UVT = 8 * MiB + MiB / 4,
                 W_OUT0T = 8 * MiB + 3 * MiB / 4, W_MEMT = 12 * MiB, W_ROPE = 16 * MiB, W_MEMB = 20 * MiB,
                 W_XB0 = 21 * MiB, W_LATALL = 57 * MiB, W_KRALL = 82 * MiB, W_MEMKS0 = 89 * MiB, W_MEMVTS0 = 97 * MiB,
                 W_P0F = 105 * MiB, W_CQN = 281 * MiB, W_XQ0 = 209 * MiB, W_Q = 227 * MiB, W_KNP = 105 * MiB,
                 W_VTP = 137 * MiB, W_KNS = 169 * MiB, W_VTS = 21 * MiB, W_Y7 = 105 * MiB, W_UP0T = 220 * MiB, W_DOWN0T = 228 * MiB, W_HID0 = 76 * MiB,
                 W_Y10 = 4 * MiB;
constexpr size_t W_XB1 = 256 * MiB, W_IN1T = 292 * MiB, W_OUT1T = 301 * MiB, W_QS = 4 * MiB, W_F = 40 * MiB,
                 W_V = 112 * MiB, W_GS = 148 * MiB, W_XQ1 = 184 * MiB, W_U = 202 * MiB, W_MEMKS1 = 112 * MiB,
                 W_MEMVTS1 = 120 * MiB, W_Y16 = 40 * MiB, W_XB2 = 4 * MiB, W_UP1T = 112 * MiB, W_DOWN1T = 120 * MiB,
                 W_HID1 = 128 * MiB, W_Y19 = 40 * MiB;
constexpr size_t W_PART7 = 177 * MiB, W_PART10 = 236 * MiB, W_PART16 = 148 * MiB, W_PART19 = 272 * MiB;

struct Params {
  const float* in[27];
  float* out;
  char* ws;
  double inv_freq[32];
  int never;
  int pad;
};
enum { I_XP = 0, I_XS, I_CLAT, I_CKR, I_CHS, I_CMK, I_CMV, I_MEMP, I_LMPRE, I_LMPOST, I_LFPRE, I_LFPOST, I_MEMNORM,
       I_WMEMKV, I_WIN0, I_QNORM, I_KVNORM, I_WUQ, I_WUK, I_WUV, I_WOUT0, I_WIN1, I_LB, I_ONORM, I_WOUT1, I_WUP, I_WDOWN };

typedef __bf16 bf16v2_t __attribute__((ext_vector_type(2)));
typedef float f32v2_t __attribute__((ext_vector_type(2)));
DI unsigned pack2(float a, float b) { f32v2_t v = {a, b}; return __builtin_bit_cast(unsigned, __builtin_convertvector(v, bf16v2_t)); }
DI u16 f2bf(float x) { return (u16)(pack2(x, 0.f) & 0xffffu); }
DI float bf2f(u16 h) { return __uint_as_float(((unsigned)h) << 16); }
typedef float f32x4n __attribute__((ext_vector_type(4)));
DI float4 ld_nt4(const float* q) { const f32x4n v = __builtin_nontemporal_load((const f32x4n*)q); return make_float4(v.x, v.y, v.z, v.w); }
DI float wave_sum(float v) {
#pragma unroll
  for (int o = 32; o >= 1; o >>= 1) v += __shfl_xor(v, o);
  return v;
}
DI char* launder(char* q) { return q; }
DI int opaque_tid() { int t = threadIdx.x; asm volatile("" : "+v"(t)); return t; }
DI int crow(int i, int h) { return (i & 3) + 8 * (i >> 2) + 4 * h; }
DI float sigmoidf_(float x) { return __builtin_amdgcn_rcpf(1.f + __expf(-x)); }
DI float siluf_(float x) { return x * __builtin_amdgcn_rcpf(1.f + __expf(-x)); }

#define XB_TMO      128
#define XB_XCNT(j)  (256  + 64 * (j))
#define XB_XSUB(j)  (1280 + 64 * (j))
#define XB_XGEN(j)  (2304 + 64 * (j))
#define XB_TOP      3328
#define XB_TOPGEN   3392
#define XCD_BAR_WORDS 3456
#define XB_SPIN_CAP (1u << 23)
#define LAS __attribute__((address_space(3)))
DI unsigned xb_ld(unsigned* p) { return __hip_atomic_load(p, __ATOMIC_RELAXED, __HIP_MEMORY_SCOPE_AGENT); }
DI unsigned xb_add(unsigned* p, unsigned v) { return __hip_atomic_fetch_add(p, v, __ATOMIC_RELAXED, __HIP_MEMORY_SCOPE_AGENT); }
DI unsigned xb_xcc_id() { return (unsigned)__builtin_amdgcn_s_getreg((3 << 11) | 20) & 0xFu; }
#define XB_SPIN(cond, bar) do { unsigned _sp = 0; while (cond) { __builtin_amdgcn_s_sleep(1); \
    if ((++_sp & 255u) == 0u) { if (xb_ld(&(bar)[XB_TMO])) break; if (_sp > XB_SPIN_CAP) { atomicAdd(&(bar)[XB_TMO], 1u); break; } } } } while (0)
struct XcdBarrier { unsigned* bar; unsigned x; volatile LAS unsigned* st; };
DI XcdBarrier xcd_barrier_post(unsigned* bar, volatile LAS unsigned* st) {
  XcdBarrier b; b.bar = bar; b.x = xb_xcc_id(); b.st = st;
  if (threadIdx.x == 0) (void)xb_add(&bar[XB_XCNT(b.x)], 1u);
  return b;
}
DI void xcd_barrier_complete(unsigned* bar, unsigned x, unsigned& nloc, unsigned& nx) {
  const unsigned G = gridDim.x * gridDim.y * gridDim.z;
  unsigned sum, cnt, mine, sp = 0u;
  for (;;) {
    sum = 0u; cnt = 0u; mine = 0u;
#pragma unroll
    for (unsigned j = 0; j < 16; ++j) { const unsigned c = xb_ld(&bar[XB_XCNT(j)]); sum += c; cnt += (c > 0u) ? 1u : 0u; mine = (j == x) ? c : mine; }
    if (sum == G) break;
    __builtin_amdgcn_s_sleep(1);
    if ((++sp & 255u) == 0u) { if (xb_ld(&bar[XB_TMO])) break; if (sp > XB_SPIN_CAP) { atomicAdd(&bar[XB_TMO], 1u); break; } }
  }
  nloc = mine > 0u ? mine : 1u; nx = cnt > 0u ? cnt : 1u;
}
DI void xcd_barrier(const XcdBarrier& b) {
  asm volatile("s_waitcnt vmcnt(0)" ::: "memory");
  __syncthreads();
  if (threadIdx.x == 0) {
    unsigned* bar = b.bar;
    __builtin_amdgcn_s_waitcnt(0);
    unsigned nloc = b.st[0], nx = b.st[1];
    if (nloc == 0u) { xcd_barrier_complete(bar, b.x, nloc, nx); b.st[0] = nloc; b.st[1] = nx; }
    const unsigned old = xb_add(&bar[XB_XSUB(b.x)], 1u);
    const unsigned gen = old / nloc;
    if (old + 1u == (gen + 1u) * nloc) {
      __builtin_amdgcn_fence(__ATOMIC_RELEASE, "agent");
      asm volatile("s_waitcnt vmcnt(0)" ::: "memory");
      const unsigned og = xb_add(&bar[XB_TOP], 1u);
      const unsigned tg = og / nx;
      if (og + 1u == (tg + 1u) * nx) xb_add(&bar[XB_TOPGEN], 1u);
      else XB_SPIN(xb_ld(&bar[XB_TOPGEN]) == tg, bar);
      __builtin_amdgcn_fence(__ATOMIC_ACQUIRE, "agent");
      xb_add(&bar[XB_XGEN(b.x)], 1u);
      asm volatile("s_waitcnt vmcnt(0)" ::: "memory");
    } else {
      XB_SPIN(xb_ld(&bar[XB_XGEN(b.x)]) == gen, bar);
      __builtin_amdgcn_fence(__ATOMIC_ACQUIRE, "agent");
      asm volatile("s_waitcnt vmcnt(0)" ::: "memory");
    }
  }
  __syncthreads();
}

constexpr int SMEM_MAIN = 73728;
constexpr int SMEM_TOTAL = SMEM_MAIN + 256;

DI void tr_tile(const float* __restrict__ src, long ld_src, int N, const float* __restrict__ gain,
                u16* __restrict__ dst, long ld_dst, int kt, int nt, float* tile  ) {
  const int tid = opaque_tid();
  const bool inside = nt * 64 < N;
  float4 v[4];
#pragma unroll
  for (int j = 0; j < 4; j++) {
    const int idx = tid + 256 * j, r = idx >> 4, c4 = idx & 15;
    v[j] = make_float4(0.f, 0.f, 0.f, 0.f);
    if (inside) {
      v[j] = ld_nt4(src + (long)(kt * 64 + r) * ld_src + nt * 64 + c4 * 4);
      if (gain) { const float g = gain[kt * 64 + r]; v[j].x *= g; v[j].y *= g; v[j].z *= g; v[j].w *= g; }
    }
  }
#pragma unroll
  for (int j = 0; j < 4; j++) {
    const int idx = tid + 256 * j, r = idx >> 4, c4 = idx & 15;
    float* tp = tile + r * 65 + c4 * 4;
    tp[0] = v[j].x; tp[1] = v[j].y; tp[2] = v[j].z; tp[3] = v[j].w;
  }
  __syncthreads();
#pragma unroll
  for (int j = 0; j < 2; j++) {
    const int idx = tid + 256 * j, rn = idx >> 3, ck = idx & 7;
    const float* tp = tile + (ck * 8) * 65 + rn;
    uint4 o;
    o.x = pack2(tp[0], tp[65]); o.y = pack2(tp[2 * 65], tp[3 * 65]); o.z = pack2(tp[4 * 65], tp[5 * 65]); o.w = pack2(tp[6 * 65], tp[7 * 65]);
    *(uint4*)(dst + (long)(nt * 64 + rn) * ld_dst + kt * 64 + ck * 8) = o;
  }
  __syncthreads();
}
DI void convert_weight(const float* src, int K, int N, int Npad, const float* gain, u16* dst, char* smem, int rot = 0) {
  const int nkt = K / 64, nnt = Npad / 64;
  const int b0 = (int)((blockIdx.x + gridDim.x - (unsigned)rot % gridDim.x) % gridDim.x);
  for (int i = b0; i < nkt * nnt; i += gridDim.x) tr_tile(src, N, N, gain, dst, K, i % nkt, i / nkt, (float*)smem);
}
DI void convert_mem_cache(const Params& p, int l, u16* memk_s, u16* memvT_s, char* smem) {
  const float* ck = p.in[I_CMK] + (long)l * 32 * 256 * 512;
  const long n4 = 32L * 256 * 512 / 4;
  const int tid = opaque_tid();
  for (long i = (long)blockIdx.x * 256 + tid; i < n4; i += (long)gridDim.x * 256) {
    const float4 v = ld_nt4(ck + i * 4);
    uint2 o; o.x = pack2(v.x, v.y); o.y = pack2(v.z, v.w);
    ((uint2*)memk_s)[i] = o;
  }
  const float* cv = p.in[I_CMV] + (long)l * 32 * 256 * 512;
  for (int i = blockIdx.x; i < 128 * 8; i += gridDim.x) {
    const int bh = i >> 3, t = i & 7, b = bh >> 2, h = bh & 3;
    tr_tile(cv + (long)b * 256 * 512 + h * 128, 512, 128, nullptr, memvT_s + (long)bh * 128 * 256, 256, t & 3, t >> 2, (float*)smem);
  }
}

template <class AL, class BL>
DI void gemm_core(AL al, BL bl, int m0, int n0, int K, char* smem, f32x16 (&acc)[2][2]) {
  const int tid = opaque_tid(), lane = tid & 63, w = tid >> 6, wm = w >> 1, wn = w & 1;
  u16* As = (u16*)smem;
  u16* Bs = As + 2 * 128 * 72;
  uint4 xa0, xa1, xa2, xa3, xb0, xb1, xb2, xb3, ya0, ya1, ya2, ya3, yb0, yb1, yb2, yb3;
  const int nk = K / 64;
#pragma unroll
  for (int mt = 0; mt < 2; mt++)
#pragma unroll
    for (int nt = 0; nt < 2; nt++)
#pragma unroll
      for (int i = 0; i < 16; i++) acc[mt][nt][i] = 0.f;
  const int srow = tid >> 3, sch = tid & 7;
#define G_LD1(RA, RB, i_, kt_) RA = *(const uint4*)al(m0 + srow + 32 * (i_), (kt_) * 64 + sch * 8); RB = *(const uint4*)bl(n0 + srow + 32 * (i_), (kt_) * 64 + sch * 8)
#define G_LOAD(S, kt_) do { G_LD1(S##a0, S##b0, 0, kt_); G_LD1(S##a1, S##b1, 1, kt_); G_LD1(S##a2, S##b2, 2, kt_); G_LD1(S##a3, S##b3, 3, kt_); } while (0)
#define G_ST1(RA, RB, i_, buf_) *(uint4*)(As + ((buf_) * 128 + srow + 32 * (i_)) * 72 + sch * 8) = RA; *(uint4*)(Bs + ((buf_) * 128 + srow + 32 * (i_)) * 72 + sch * 8) = RB
#define G_STORE(S, buf_) do { G_ST1(S##a0, S##b0, 0, buf_); G_ST1(S##a1, S##b1, 1, buf_); G_ST1(S##a2, S##b2, 2, buf_); G_ST1(S##a3, S##b3, 3, buf_); } while (0)
#define G_FRAG(AF, BF, buf_, ks_) do { \
    const u16* Ab = As + (buf_) * 128 * 72; const u16* Bb = Bs + (buf_) * 128 * 72; \
    AF[0] = *(const bf16x8*)(Ab + (wm * 64 + (lane & 31)) * 72 + (ks_) * 16 + (lane >> 5) * 8); \
    AF[1] = *(const bf16x8*)(Ab + (wm * 64 + 32 + (lane & 31)) * 72 + (ks_) * 16 + (lane >> 5) * 8); \
    BF[0] = *(const bf16x8*)(Bb + (wn * 64 + (lane & 31)) * 72 + (ks_) * 16 + (lane >> 5) * 8); \
    BF[1] = *(const bf16x8*)(Bb + (wn * 64 + 32 + (lane & 31)) * 72 + (ks_) * 16 + (lane >> 5) * 8); } while (0)
#define G_MMA(AF, BF) do { \
    acc[0][0] = MFMA(AF[0], BF[0], acc[0][0]); acc[0][1] = MFMA(AF[0], BF[1], acc[0][1]); \
    acc[1][0] = MFMA(AF[1], BF[0], acc[1][0]); acc[1][1] = MFMA(AF[1], BF[1], acc[1][1]); } while (0)
#define G_STEP(buf_, S, ks_, AF, BF, AN, BN, do_st, do_ld, ktn_) do { \
    if ((ks_) < 3) G_FRAG(AN, BN, buf_, (ks_) + 1); \
    G_MMA(AF, BF); \
    if (do_st) { G_ST1(S##a##ks_, S##b##ks_, ks_, (buf_) ^ 1); } \
    if (do_ld) { G_LD1(S##a##ks_, S##b##ks_, ks_, ktn_); } \
    __builtin_amdgcn_sched_barrier(0); } while (0)
#define G_TILE(buf_, S, do_st, do_ld, ktn_) do { \
    bf16x8 fa0[2], fb0[2], fa1[2], fb1[2]; \
    G_FRAG(fa0, fb0, buf_, 0); \
    G_STEP(buf_, S, 0, fa0, fb0, fa1, fb1, do_st, do_ld, ktn_); \
    G_STEP(buf_, S, 1, fa1, fb1, fa0, fb0, do_st, do_ld, ktn_); \
    G_STEP(buf_, S, 2, fa0, fb0, fa1, fb1, do_st, do_ld, ktn_); \
    G_STEP(buf_, S, 3, fa1, fb1, fa0, fb0, do_st, do_ld, ktn_); } while (0)
  G_LOAD(x, 0);
  G_STORE(x, 0);
  G_LOAD(x, 1);
  G_LOAD(y, (nk > 2) ? 2 : 1);
  __syncthreads();
  for (int kt = 0; kt < nk; kt += 2) {
    G_TILE(0, x, true, (kt + 3 < nk), kt + 3);
    __syncthreads();
    G_TILE(1, y, (kt + 2 < nk), (kt + 4 < nk), kt + 4);
    __syncthreads();
  }
#undef G_LD1
#undef G_ST1
#undef G_LOAD
#undef G_STORE
#undef G_FRAG
#undef G_MMA
#undef G_STEP
#undef G_TILE
}
template <class F>
DI void epi_each(const f32x16 (&acc)[2][2], int m0, int n0, F f) {
  const int tid = opaque_tid(), lane = tid & 63, w = tid >> 6, wm = w >> 1, wn = w & 1, h = lane >> 5;
#pragma unroll
  for (int mt = 0; mt < 2; mt++)
#pragma unroll
    for (int nt = 0; nt < 2; nt++)
#pragma unroll
      for (int i = 0; i < 16; i++)
        f(m0 + wm * 64 + mt * 32 + crow(i, h), n0 + wn * 64 + nt * 32 + (lane & 31), acc[mt][nt][i]);
}

template <class F>
DI void epi_bf16_tile(const f32x16 (&acc)[2][2], int m0, int n0, u16* dst0, long ld, char* smem, F f) {
  const int tid = opaque_tid(), lane = tid & 63, w = tid >> 6, wm = w >> 1, wn = w & 1, h = lane >> 5;
  u16* T = (u16*)smem;
#pragma unroll
  for (int mt = 0; mt < 2; mt++)
#pragma unroll
    for (int nt = 0; nt < 2; nt++)
#pragma unroll
      for (int i = 0; i < 16; i++) {
        const int ml = wm * 64 + mt * 32 + crow(i, h), nl = wn * 64 + nt * 32 + (lane & 31);
        T[ml * 136 + nl] = f2bf(f(m0 + ml, n0 + nl, acc[mt][nt][i]));
      }
  __syncthreads();
#pragma unroll
  for (int j = 0; j < 8; j++) {
    const int idx = tid + 256 * j, row = idx >> 4, ch = idx & 15;
    *(uint4*)(dst0 + (long)row * ld + ch * 8) = *(const uint4*)(T + row * 136 + ch * 8);
  }
  __syncthreads();
}

template <class F>
DI void epi_bf16_vtile(const f32x16 (&acc)[2][2], u16* dst0  , char* smem, F f) {
  const int tid = opaque_tid(), lane = tid & 63, w = tid >> 6, wm = w >> 1, wn = w & 1, h = lane >> 5;
  u16* T = (u16*)smem;
#pragma unroll
  for (int mt = 0; mt < 2; mt++)
#pragma unroll
    for (int nt = 0; nt < 2; nt++)
#pragma unroll
      for (int i = 0; i < 16; i++) {
        const int ml = wm * 64 + mt * 32 + crow(i, h), nl = wn * 64 + nt * 32 + (lane & 31);
        T[ml * 136 + nl] = f2bf(f(acc[mt][nt][i]));
      }
  __syncthreads();
#pragma unroll
  for (int j = 0; j < 8; j++) {
    const int idx = tid + 256 * j, row = idx >> 4, ch = idx & 15;
    *(uint4*)(dst0 + ((long)(ch >> 3) * 128 + row) * 64 + (ch & 7) * 8) = *(const uint4*)(T + row * 136 + ch * 8);
  }
  __syncthreads();
}

template <int DQK>
DI void attn_item(const u16* Qb, long ldq, const u16* K1, long ldk1, const u16* K2, long ldk2,
                  const u16* VT, long ldvt, int nkt, int nkt_w, u16* Ob, long ldo, char* smem, bool rev = false, int vtile = 64) {
  constexpr int KLD = DQK + 8;
  constexpr int NCH = DQK / 8;
  constexpr int NKC = 64 * NCH / 256;
  constexpr int NQF = DQK / 16;
  u16* Ks = (u16*)smem;
  u16* Vs = Ks + 64 * KLD;
  int tid_ = threadIdx.x;
  asm volatile("" : "+v"(tid_));
  const int tid = tid_, lane = tid & 63, w = tid >> 6, h = lane >> 5, r = lane & 31;
  constexpr int NQR = (NQF > 8) ? 8 : NQF;
  bf16x8 qf[NQR];
  const u16* qp = Qb + (long)(w * 32 + r) * ldq + h * 8;
  if (nkt_w > 0) {
#pragma unroll
    for (int ks = 0; ks < NQR; ks++) qf[ks] = *(const bf16x8*)(qp + ks * 16);
  } else {
#pragma unroll
    for (int ks = 0; ks < NQR; ks++) qf[ks] = (bf16x8){0, 0, 0, 0, 0, 0, 0, 0};
  }
  u16* Qs = Vs + 128 * 68;
  if (NQF > NQR) {
    const int qrow = tid >> 1, qhalf = tid & 1;
    const bool qvalid = (nkt_w > 0) || (qrow < 64);
    const u16* qsrc = Qb + (long)qrow * ldq + NQR * 16 + qhalf * 32;
#pragma unroll
    for (int c = 0; c < 4; c++) {
      uint4 v = make_uint4(0, 0, 0, 0);
      if (qvalid) v = *(const uint4*)(qsrc + c * 8);
      *(uint4*)(Qs + qrow * 72 + qhalf * 32 + c * 8) = v;
    }
  }
  f32x16 o[4];
#pragma unroll
  for (int mc = 0; mc < 4; mc++)
#pragma unroll
    for (int i = 0; i < 16; i++) o[mc][i] = 0.f;
  float m_run = -1e30f, l_run = 0.f;
  uint4 rk0, rk1, rk2, rk3, rk4 = make_uint4(0, 0, 0, 0), rk5 = make_uint4(0, 0, 0, 0), rv0, rv1, rv2, rv3;
  const unsigned voffK = (unsigned)(((tid >> 4) * (int)ldk1 + (tid & 15) * 8) * 2);
  const unsigned voffR = (unsigned)(((tid >> 3) * (int)ldk2 + (tid & 7) * 8) * 2);
  const unsigned voffV = (unsigned)(((tid >> 3) * (int)ldvt + (tid & 7) * 8) * 2);
  u16* const ldsK = Ks + (tid >> 4) * KLD + (tid & 15) * 8;
  u16* const ldsR = Ks + (tid >> 3) * KLD + (16 + (tid & 7)) * 8;
  u16* const ldsV = Vs + (tid >> 3) * 68 + (tid & 7) * 8;
#define ATT_KP(i_, kt_) ((const char*)K1 + ((long)((kt_) * 64 + 16 * (i_)) * ldk1) * 2 + voffK)
#define ATT_RP(i_, kt_) ((const char*)K2 + ((long)((kt_) * 64 + 32 * (i_)) * ldk2) * 2 + voffR)
#define ATT_VP(i_, kt_) ((const char*)VT + ((long)(32 * (i_)) * ldvt + (long)(kt_) * vtile) * 2 + voffV)
#define ATT_GLOAD(kt_) do { \
    rk0 = *(const uint4*)ATT_KP(0, kt_); rk1 = *(const uint4*)ATT_KP(1, kt_); \
    rk2 = *(const uint4*)ATT_KP(2, kt_); rk3 = *(const uint4*)ATT_KP(3, kt_); \
    if (DQK == 192) { rk4 = *(const uint4*)ATT_RP(0, kt_); rk5 = *(const uint4*)ATT_RP(1, kt_); } \
    rv0 = *(const uint4*)ATT_VP(0, kt_); rv1 = *(const uint4*)ATT_VP(1, kt_); \
    rv2 = *(const uint4*)ATT_VP(2, kt_); rv3 = *(const uint4*)ATT_VP(3, kt_); } while (0)
#define ATT_VST(i_, v_) do { uint2* d_ = (uint2*)(ldsV + 32 * (i_) * 68); \
    d_[0] = make_uint2((v_).x, (v_).y); d_[1] = make_uint2((v_).z, (v_).w); } while (0)
#define ATT_SSTORE() do { \
    *(uint4*)(ldsK) = rk0; *(uint4*)(ldsK + 16 * KLD) = rk1; *(uint4*)(ldsK + 32 * KLD) = rk2; *(uint4*)(ldsK + 48 * KLD) = rk3; \
    if (DQK == 192) { *(uint4*)(ldsR) = rk4; *(uint4*)(ldsR + 32 * KLD) = rk5; } \
    ATT_VST(0, rv0); ATT_VST(1, rv1); ATT_VST(2, rv2); ATT_VST(3, rv3); } while (0)
  ATT_GLOAD(rev ? nkt - 1 : 0);
  for (int kt = 0; kt < nkt; kt++) {
    __syncthreads();
    ATT_SSTORE();
    __syncthreads();
    const int ktile = rev ? nkt - 1 - kt : kt;
    const bool active = ktile < nkt_w;
    f32x16 s[2];
    if (active) {
      const f32x16 zero16 = {0.f, 0.f, 0.f, 0.f, 0.f, 0.f, 0.f, 0.f, 0.f, 0.f, 0.f, 0.f, 0.f, 0.f, 0.f, 0.f};
      bf16x8 qx[(NQF > NQR) ? (NQF - NQR) : 1];
      if (NQF > NQR) {
#pragma unroll
        for (int ks = NQR; ks < NQF; ks++) qx[ks - NQR] = *(const bf16x8*)(Qs + (w * 32 + r) * 72 + (ks - NQR) * 16 + h * 8);
      }
      __builtin_amdgcn_s_setprio(1);
#pragma unroll
      for (int ks = 0; ks < NQF; ks++) {
#pragma unroll
        for (int mt = 0; mt < 2; mt++) {
          const bf16x8 kf = *(const bf16x8*)(Ks + (mt * 32 + r) * KLD + ks * 16 + h * 8);
          s[mt] = MFMA(kf, (ks < NQR) ? qf[ks < NQR ? ks : 0] : qx[ks >= NQR ? ks - NQR : 0], (ks == 0) ? zero16 : s[mt]);
        }
      }
      __builtin_amdgcn_s_setprio(0);
    }
    __builtin_amdgcn_sched_barrier(0);
    if (kt + 1 < nkt) ATT_GLOAD(rev ? ktile - 1 : ktile + 1);
    __builtin_amdgcn_sched_barrier(0);
    if (active) {
      float mx = s[0][0];
#pragma unroll
      for (int mt = 0; mt < 2; mt++)
#pragma unroll
        for (int i = 0; i < 16; i++) mx = fmaxf(mx, s[mt][i]);
      mx = fmaxf(mx, __shfl_xor(mx, 32));
      if (__builtin_amdgcn_ballot_w64(mx > m_run + 8.f) != 0ull) {
        const float m_new = fmaxf(m_run, mx);
        const float alpha = __builtin_amdgcn_exp2f(m_run - m_new);
        m_run = m_new;
        l_run *= alpha;
#pragma unroll
        for (int mc = 0; mc < 4; mc++)
#pragma unroll
          for (int i = 0; i < 16; i++) o[mc][i] *= alpha;
      }
      float sum = 0.f;
#pragma unroll
      for (int mt = 0; mt < 2; mt++)
#pragma unroll
        for (int i = 0; i < 16; i++) { const float e = __builtin_amdgcn_exp2f(s[mt][i] - m_run); s[mt][i] = e; sum += e; }
      l_run += sum;
      __builtin_amdgcn_s_setprio(1);
#pragma unroll
      for (int mt = 0; mt < 2; mt++) {
#pragma unroll
        for (int sp = 0; sp < 2; sp++) {
          const int st = 2 * mt + sp;
          unsigned pp[4];
#pragma unroll
          for (int j = 0; j < 4; j++) pp[j] = pack2(s[mt][8 * sp + 2 * j], s[mt][8 * sp + 2 * j + 1]);
          const bf16x8 pf = __builtin_bit_cast(bf16x8, make_uint4(pp[0], pp[1], pp[2], pp[3]));
#pragma unroll
          for (int mc = 0; mc < 4; mc++) {
            const u16* vp = Vs + (mc * 32 + r) * 68 + 16 * st + 4 * h;
            const uint2 lo = *(const uint2*)vp;
            const uint2 hi = *(const uint2*)(vp + 8);
            const bf16x8 vf = __builtin_bit_cast(bf16x8, make_uint4(lo.x, lo.y, hi.x, hi.y));
            o[mc] = MFMA(vf, pf, o[mc]);
          }
        }
      }
      __builtin_amdgcn_s_setprio(0);
    }
  }
  if (nkt_w > 0) {
    const float l = l_run + __shfl_xor(l_run, 32);
    const float inv = __builtin_amdgcn_rcpf(l);
    u16* op = Ob + (long)(w * 32 + r) * ldo;
#pragma unroll
    for (int mc = 0; mc < 4; mc++)
#pragma unroll
      for (int g = 0; g < 4; g++) {
        uint2 v;
        v.x = pack2(o[mc][4 * g] * inv, o[mc][4 * g + 1] * inv);
        v.y = pack2(o[mc][4 * g + 2] * inv, o[mc][4 * g + 3] * inv);
        *(uint2*)(op + mc * 32 + 8 * g + 4 * h) = v;
      }
  }
}

DI const float* xrow(const Params& p, int t) { return t < NP ? p.in[I_XP] + (long)t * 1024 : p.in[I_XS] + (long)(t - NP) * 1024; }
DI int tok_pos(int t) { return t < NP ? t : 1024 + ((t - NP) & 63); }
DI int tok_kv(int t) { return t < NP ? t : NP + ((t - NP) >> 6) * 1088 + 1024 + ((t - NP) & 63); }

constexpr int XR_LD = 2048;
DI u16* xres_base(const Params& p) { return (u16*)(p.out + O_Y) + 1024; }
DI void rowwise_residual(const Params& p, const u16* Y, const float* gpost, int mode, const u16* parts) {
  const int tid = opaque_tid(), lane = tid & 63, w = tid >> 6;
  float* y = p.out + O_Y;
  u16* xr = xres_base(p);
  float* rs = (float*)(p.ws + W_RS);
  const int stride = gridDim.x * 4;
  for (int tb = blockIdx.x * 4 + w; tb < NT; tb += 2 * stride) {
    float4 yv[2][4], xv[2][4];
    float ss[2] = {0.f, 0.f};
#pragma unroll
    for (int u = 0; u < 2; u++) {
      const int t = tb + u * stride;
      if (t < NT) {
#pragma unroll
        for (int j = 0; j < 4; j++) {
          const uint2 yr = *(const uint2*)(Y + (long)t * 1024 + j * 256 + lane * 4);
          yv[u][j] = make_float4(bf2f((u16)(yr.x & 0xffff)), bf2f((u16)(yr.x >> 16)), bf2f((u16)(yr.y & 0xffff)), bf2f((u16)(yr.y >> 16)));
          if (mode == 0) xv[u][j] = *(const float4*)(xrow(p, t) + j * 256 + lane * 4);
          else {
            const uint2 xq_ = *(const uint2*)(xr + (long)t * XR_LD + j * 256 + lane * 4);
            xv[u][j] = make_float4(bf2f((u16)(xq_.x & 0xffff)), bf2f((u16)(xq_.x >> 16)), bf2f((u16)(xq_.y & 0xffff)), bf2f((u16)(xq_.y >> 16)));
          }
        }
        if (lane >= 32 && t >= 2048) {
#pragma unroll
          for (int q = 0; q < 3; q++) {
            const uint2 pv = *(const uint2*)(parts + ((long)q * NT + t) * 128 + (lane - 32) * 4);
            yv[u][3].x += bf2f((u16)(pv.x & 0xffff)); yv[u][3].y += bf2f((u16)(pv.x >> 16));
            yv[u][3].z += bf2f((u16)(pv.y & 0xffff)); yv[u][3].w += bf2f((u16)(pv.y >> 16));
          }
        }
#pragma unroll
        for (int j = 0; j < 4; j++) ss[u] += yv[u][j].x * yv[u][j].x + yv[u][j].y * yv[u][j].y + yv[u][j].z * yv[u][j].z + yv[u][j].w * yv[u][j].w;
      }
    }
    ss[0] = wave_sum(ss[0]); ss[1] = wave_sum(ss[1]);
#pragma unroll
    for (int u = 0; u < 2; u++) {
      const int t = tb + u * stride;
      if (t < NT) {
        const float r = rsqrtf(ss[u] * (1.f / 1024.f) + EPS);
        float s2 = 0.f;
#pragma unroll
        for (int j = 0; j < 4; j++) {
          const float4 g = *(const float4*)(gpost + j * 256 + lane * 4);
          float4 xn = xv[u][j];
          xn.x += yv[u][j].x * r * g.x; xn.y += yv[u][j].y * r * g.y; xn.z += yv[u][j].z * r * g.z; xn.w += yv[u][j].w * r * g.w;
          s2 += xn.x * xn.x + xn.y * xn.y + xn.z * xn.z + xn.w * xn.w;
          if (mode == 2) *(float4*)(y + (long)t * 1024 + j * 256 + lane * 4) = xn;
          else {
            uint2 o; o.x = pack2(xn.x, xn.y); o.y = pack2(xn.z, xn.w);
            *(uint2*)(xr + (long)t * XR_LD + j * 256 + lane * 4) = o;
          }
        }
        if (mode != 2) {
          s2 = wave_sum(s2);
          if (lane == 0) rs[t] = rsqrtf(s2 * (1.f / 1024.f) + EPS);
        }
      }
    }
  }
}

constexpr int NSKV = 32 * 1088;
DI void attn_phase_l0(const Params& p, int g, unsigned* qcnt, char* smem) {
  char* ws = launder(p.ws);
  u16* Q = (u16*)(ws + W_Q);
  const u16* knp = (const u16*)(ws + W_KNP);
  const u16* vtp = (const u16*)(ws + W_VTP);
  const u16* kns = (const u16*)(ws + W_KNS);
  const u16* vts = (const u16*)(ws + W_VTS);
  const u16* krall = (const u16*)(ws + W_KRALL);
  u16* xq = (u16*)(ws + W_XQ0);
  const u16* memk_p = (const u16*)(ws + W_MEMKP);
  const u16* memvT_p = (const u16*)(ws + W_MEMVTP);
  const u16* memk_s = (const u16*)(ws + W_MEMKS0);
  const u16* memvT_s = (const u16*)(ws + W_MEMVTS0);
  volatile int* qslot = (volatile int*)(smem + SMEM_MAIN + 16);
  const int n_mla_p = (g == 0) ? 1024 : 0, n_mla_s = 128, n_cross = (g == 0) ? 512 + 128 : 0;
  const int total = n_mla_p + n_mla_s + n_cross;
  int hoff = (g == 0) ? 0 : 8;
  const int h0 = (int)(xb_xcc_id() & 7u);
  for (;;) {
    __syncthreads();
    if (threadIdx.x == 0) {
      int item = -1;
      while (hoff < 8) {
        const int hd_ = (h0 + hoff) & 7;
        const unsigned k_ = atomicAdd(qcnt + 8 + hd_, 1u);
        if (k_ < 128u) { item = (int)k_ * 8 + hd_; break; }
        hoff++;
      }
      if (item < 0) item = n_mla_p + (int)atomicAdd(qcnt, 1u);
      *qslot = item;
    }
    __syncthreads();
    const int it = *qslot;
    if (it >= total) break;
    const int w = threadIdx.x >> 6;
    if (it < n_mla_p) {
      const int qt = 127 - (it >> 3), hd = it & 7;
      const int nkt = 2 * qt + 2, nkw = (w < 2) ? 2 * qt + 1 : 2 * qt + 2;
      u16* qb = Q + (long)qt * 128 * 1536 + hd * 192;
      attn_item<192>(qb, 1536, knp + (long)hd * NP * 128, 128, krall, 64, vtp + (long)hd * (NP / 64) * 8192, 64, nkt, nkw, qb, 1536, smem, qt < 64, 8192);
    } else if (it < n_mla_p + n_mla_s) {
      const int j = it - n_mla_p, b = j >> 2, hl = j & 3, hd = 4 * g + hl;
      const long s0 = (long)b * 1088;
      u16* qb = Q + (long)(NP + b * 64) * 1536 + hd * 192;
      attn_item<192>(qb, 1536, kns + ((long)hl * NSKV + s0) * 128, 128, krall + ((long)NP + s0) * 64, 64, vts + ((long)hl * (NSKV / 64) + b * 17) * 8192, 64,
                     17, (w < 2) ? 17 : 0, qb, 1536, smem, false, 8192);
    } else {
      const int j = it - n_mla_p - n_mla_s;
      if (j < 512) {
        const int qt = j >> 2, hx = j & 3;
        u16* qb = xq + (long)qt * 128 * 512 + hx * 128;
        attn_item<128>(qb, 512, memk_p + hx * 128, 512, nullptr, 0, memvT_p + (long)hx * 128 * 256, 256, 4, 4, qb, 512, smem);
      } else {
        const int jj = j - 512, b = jj >> 2, hx = jj & 3;
        u16* qb = xq + (long)(NP + b * 64) * 512 + hx * 128;
        attn_item<128>(qb, 512, memk_s + (long)b * 256 * 512 + hx * 128, 512, nullptr, 0,
                       memvT_s + (long)(b * 4 + hx) * 128 * 256, 256, 4, (w < 2) ? 4 : 0, qb, 512, smem);
      }
    }
  }
}
DI void cross_phase_l1(const Params& p, unsigned* qcnt, char* smem) {
  char* ws = launder(p.ws);
  u16* xq = (u16*)(ws + W_XQ1);
  const u16* memk_p = (const u16*)(ws + W_MEMKP) + 256 * 512;
  const u16* memvT_p = (const u16*)(ws + W_MEMVTP) + 4 * 128 * 256;
  const u16* memk_s = (const u16*)(ws + W_MEMKS1);
  const u16* memvT_s = (const u16*)(ws + W_MEMVTS1);
  volatile int* qslot = (volatile int*)(smem + SMEM_MAIN + 16);
  for (;;) {
    __syncthreads();
    if (threadIdx.x == 0) *qslot = (int)atomicAdd(qcnt, 1u);
    __syncthreads();
    const int j = *qslot;
    if (j >= 640) break;
    const int w = threadIdx.x >> 6;
    if (j < 512) {
      const int qt = j >> 2, hx = j & 3;
      u16* qb = xq + (long)qt * 128 * 512 + hx * 128;
      attn_item<128>(qb, 512, memk_p + hx * 128, 512, nullptr, 0, memvT_p + (long)hx * 128 * 256, 256, 4, 4, qb, 512, smem);
    } else {
      const int jj = j - 512, b = jj >> 2, hx = jj & 3;
      u16* qb = xq + (long)(NP + b * 64) * 512 + hx * 128;
      attn_item<128>(qb, 512, memk_s + (long)b * 256 * 512 + hx * 128, 512, nullptr, 0,
                     memvT_s + (long)(b * 4 + hx) * 128 * 256, 256, 4, (w < 2) ? 4 : 0, qb, 512, smem);
    }
  }
}

DI void hgrn_chunk_item(const Params& p, int n, int hd, char* smem) {
  char* ws = launder(p.ws);
  u16* qs = (u16*)(ws + W_QS);
  float* f = (float*)(ws + W_F);
  const u16* vv = (const u16*)(ws + W_V);
  u16* U = (u16*)(ws + W_U);
  float* decay = (float*)(ws + W_DECAY);
  const float* lbv = (const float*)(ws + W_LBV);
  u16* QS = (u16*)smem;
  u16* KS = QS + 64 * 136;
  u16* KDT = KS + 64 * 136;
  u16* VTs = KDT + 128 * 68;
  float* tot = (float*)(VTs + 128 * 68);
  float* lg32 = tot + 256;
  const int tid = opaque_tid(), lane = tid & 63, w = tid >> 6, h = lane >> 5, r = lane & 31;
  const int d = tid & 127, hf = tid >> 7;
  const long t0 = (n < 256) ? (long)n * 64 : (long)NP + (long)(n - 256) * 64;
  const int col = hd * 128 + d;
  const float lb = lbv[col];
  __syncthreads();
  {
    float run = 0.f;
#pragma unroll 1
    for (int j0 = 0; j0 < 32; j0 += 16) {
      float fv[16];
#pragma unroll
      for (int jj = 0; jj < 16; jj++) fv[jj] = f[(t0 + hf * 32 + j0 + jj) * 1024 + col];
#pragma unroll
      for (int jj = 0; jj < 16; jj++) {
        const float lg = __logf(lb + (1.f - lb) * sigmoidf_(fv[jj]));
        if (j0 + jj == 0 && hf == 1) lg32[d] = lg;
        run += lg;
      }
    }
    tot[hf * 128 + d] = run;
  }
  __syncthreads();
  {
    const float tot0 = tot[d], blast = tot0 + tot[128 + d], ref = tot0 + lg32[d];
    float b = hf ? tot0 : 0.f;
    if (hf == 0) decay[((long)n * 8 + hd) * 128 + d] = __expf(blast);
#pragma unroll 1
    for (int j0 = 0; j0 < 32; j0 += 8) {
      float fv[8]; u16 qv[8], vv8[8];
#pragma unroll
      for (int jj = 0; jj < 8; jj++) {
        const long gi = (t0 + hf * 32 + j0 + jj) * 1024 + col;
        fv[jj] = f[gi]; qv[jj] = qs[gi]; vv8[jj] = vv[gi];
      }
#pragma unroll
      for (int jj = 0; jj < 8; jj++) {
        const int t = hf * 32 + j0 + jj;
        const long gi = (t0 + t) * 1024 + col;
        const float sg = sigmoidf_(fv[jj]);
        b += __logf(lb + (1.f - lb) * sg);
        const float kk = (1.f - lb) * sigmoidf_(-fv[jj]);
        const float q = bf2f(qv[jj]);
        QS[t * 136 + d] = f2bf(q * __expf(b - ref));
        KS[t * 136 + d] = f2bf(kk * __expf(ref - b));
        KDT[d * 68 + t] = f2bf(kk * __expf(blast - b));
        VTs[d * 68 + t] = vv8[jj];
        qs[gi] = f2bf(q * __expf(b));
      }
    }
  }
  __syncthreads();
  {
    const int ntl = w & 1, vh = w >> 1;
    f32x16 at[2];
#pragma unroll
    for (int ms = 0; ms < 2; ms++)
#pragma unroll
      for (int i = 0; i < 16; i++) at[ms][i] = 0.f;
#pragma unroll
    for (int ms = 0; ms < 2; ms++) {
      if (ms <= ntl) {
#pragma unroll
        for (int ks = 0; ks < 8; ks++) {
          const bf16x8 a = *(const bf16x8*)(KS + (ms * 32 + r) * 136 + ks * 16 + h * 8);
          const bf16x8 b = *(const bf16x8*)(QS + (ntl * 32 + r) * 136 + ks * 16 + h * 8);
          at[ms] = MFMA(a, b, at[ms]);
        }
        if (ms == ntl) {
#pragma unroll
          for (int i = 0; i < 16; i++) if (crow(i, h) > r) at[ms][i] = 0.f;
        }
      }
    }
    f32x16 o[2];
#pragma unroll
    for (int mv = 0; mv < 2; mv++)
#pragma unroll
      for (int i = 0; i < 16; i++) o[mv][i] = 0.f;
#pragma unroll
    for (int ms = 0; ms < 2; ms++)
#pragma unroll
      for (int sp = 0; sp < 2; sp++) {
        const int st = 2 * ms + sp;
        unsigned pp[4];
#pragma unroll
        for (int j = 0; j < 4; j++) pp[j] = pack2(at[ms][8 * sp + 2 * j], at[ms][8 * sp + 2 * j + 1]);
        const bf16x8 pf = __builtin_bit_cast(bf16x8, make_uint4(pp[0], pp[1], pp[2], pp[3]));
#pragma unroll
        for (int mv = 0; mv < 2; mv++) {
          const u16* vp = VTs + ((vh * 2 + mv) * 32 + r) * 68 + 16 * st + 4 * h;
          const uint2 lo = *(const uint2*)vp;
          const uint2 hi = *(const uint2*)(vp + 8);
          const bf16x8 vf = __builtin_bit_cast(bf16x8, make_uint4(lo.x, lo.y, hi.x, hi.y));
          o[mv] = MFMA(vf, pf, o[mv]);
        }
      }
    float* op = f + (t0 + ntl * 32 + r) * 1024 + hd * 128;
#pragma unroll
    for (int mv = 0; mv < 2; mv++)
#pragma unroll
      for (int g = 0; g < 4; g++)
        *(float4*)(op + (vh * 2 + mv) * 32 + 8 * g + 4 * h) = make_float4(o[mv][4 * g], o[mv][4 * g + 1], o[mv][4 * g + 2], o[mv][4 * g + 3]);
  }
  {
    f32x16 u[4];
#pragma unroll
    for (int nk = 0; nk < 4; nk++)
#pragma unroll
      for (int i = 0; i < 16; i++) u[nk][i] = 0.f;
#pragma unroll
    for (int ss = 0; ss < 4; ss++) {
      const u16* ap = VTs + (w * 32 + r) * 68 + ss * 16 + h * 8;
      const uint2 alo = *(const uint2*)ap, ahi = *(const uint2*)(ap + 4);
      const bf16x8 a = __builtin_bit_cast(bf16x8, make_uint4(alo.x, alo.y, ahi.x, ahi.y));
#pragma unroll
      for (int nk = 0; nk < 4; nk++) {
        const u16* bp = KDT + (nk * 32 + r) * 68 + ss * 16 + h * 8;
        const uint2 blo = *(const uint2*)bp, bhi = *(const uint2*)(bp + 4);
        const bf16x8 b = __builtin_bit_cast(bf16x8, make_uint4(blo.x, blo.y, bhi.x, bhi.y));
        u[nk] = MFMA(a, b, u[nk]);
      }
    }
    u16* up = U + ((long)n * 8 + hd) * 128 * 128;
#pragma unroll
    for (int nk = 0; nk < 4; nk++)
#pragma unroll
      for (int i = 0; i < 16; i++) up[(w * 32 + crow(i, h)) * 128 + nk * 32 + r] = f2bf(u[nk][i]);
  }
}

DI void hgrn_scan_phase(const Params& p, char* smem) {
  char* ws = launder(p.ws);
  u16* U = (u16*)(ws + W_U);
  const float* decay = (const float*)(ws + W_DECAY);
  const int tid = opaque_tid();
  for (int it = blockIdx.x; it < 512; it += gridDim.x) {
    const int hd = it >> 6, v = (it & 63) * 2 + (tid >> 7), k = tid & 127;
    u16* up = U + ((long)hd * 128 + v) * 128 + k;
    const float* dp = decay + hd * 128 + k;
    float S = 0.f;
    float cu[8], cd[8];
#pragma unroll
    for (int j = 0; j < 8; j++) { cu[j] = bf2f(up[(long)j * 131072]); cd[j] = dp[j * 1024]; }
    for (int n0 = 0; n0 < 256; n0 += 8) {
      float nu[8], nd[8];
      if (n0 + 8 < 256) {
#pragma unroll
        for (int j = 0; j < 8; j++) { nu[j] = bf2f(up[(long)(n0 + 8 + j) * 131072]); nd[j] = dp[(n0 + 8 + j) * 1024]; }
      } else {
#pragma unroll
        for (int j = 0; j < 8; j++) { nu[j] = 0.f; nd[j] = 0.f; }
      }
#pragma unroll
      for (int j = 0; j < 8; j++) { up[(long)(n0 + j) * 131072] = f2bf(S); S = cd[j] * S + cu[j]; }
#pragma unroll
      for (int j = 0; j < 8; j++) { cu[j] = nu[j]; cd[j] = nd[j]; }
    }
    p.out[O_HGP + ((long)hd * 128 + k) * 128 + v] = S;
  }
  float* t1 = (float*)smem;
  float* t2 = t1 + 32 * 33;
  for (int it = blockIdx.x; it < 4096; it += gridDim.x) {
    const int bh = it >> 4, kt = (it >> 2) & 3, vt = it & 3, b = bh >> 3, hd = bh & 7;
    const float* s0 = p.in[I_CHS] + (long)bh * 16384;
    float* so = p.out + O_HGS + (long)bh * 16384;
    const int n = 256 + b;
    u16* up = U + ((long)n * 8 + hd) * 16384;
    const float* dp = decay + ((long)n * 8 + hd) * 128;
    const int c = tid & 31, r0 = tid >> 5;
    __syncthreads();
#pragma unroll
    for (int j = 0; j < 4; j++) { const int rr = r0 + 8 * j; t1[rr * 33 + c] = s0[(kt * 32 + rr) * 128 + vt * 32 + c]; }
    __syncthreads();
#pragma unroll
    for (int j = 0; j < 4; j++) {
      const int vl = r0 + 8 * j, kl = c;
      const float sv = t1[kl * 33 + vl];
      const long ui = (long)(vt * 32 + vl) * 128 + kt * 32 + kl;
      const float uv = bf2f(up[ui]);
      up[ui] = f2bf(sv);
      t2[kl * 33 + vl] = dp[kt * 32 + kl] * sv + uv;
    }
    __syncthreads();
#pragma unroll
    for (int j = 0; j < 4; j++) { const int rr = r0 + 8 * j; so[(kt * 32 + rr) * 128 + vt * 32 + c] = t2[rr * 33 + c]; }
  }
}

DI void hgrn_final_item(const Params& p, int n, int hd, char* smem) {
  char* ws = launder(p.ws);
  u16* qb = (u16*)(ws + W_QS);
  const float* oi = (const float*)(ws + W_F);
  const u16* gs = (const u16*)(ws + W_GS);
  const u16* U = (const u16*)(ws + W_U);
  const float* gon = p.in[I_ONORM];
  u16* Ss = (u16*)smem;
  u16* Qb = Ss + 128 * 136;
  float* T = (float*)smem;
  const int tid = opaque_tid(), lane = tid & 63, w = tid >> 6, h = lane >> 5, r = lane & 31;
  const int ntl = w & 1, vh = w >> 1;
  const long t0 = (n < 256) ? (long)n * 64 : (long)NP + (long)(n - 256) * 64;
  const u16* sp = U + ((long)n * 8 + hd) * 16384;
  __syncthreads();
  {
    uint4 sv[8], qv[4];
    const int row = tid >> 4, ch = tid & 15;
#pragma unroll
    for (int j = 0; j < 8; j++) sv[j] = *(const uint4*)(sp + (row + 16 * j) * 128 + ch * 8);
#pragma unroll
    for (int j = 0; j < 4; j++) qv[j] = *(const uint4*)(qb + (t0 + row + 16 * j) * 1024 + hd * 128 + ch * 8);
#pragma unroll
    for (int j = 0; j < 8; j++) *(uint4*)(Ss + (row + 16 * j) * 136 + ch * 8) = sv[j];
#pragma unroll
    for (int j = 0; j < 4; j++) *(uint4*)(Qb + (row + 16 * j) * 136 + ch * 8) = qv[j];
  }
  __syncthreads();
  f32x16 o[2];
#pragma unroll
  for (int mv = 0; mv < 2; mv++)
#pragma unroll
    for (int i = 0; i < 16; i++) o[mv][i] = 0.f;
#pragma unroll
  for (int ks = 0; ks < 8; ks++) {
    const bf16x8 b = *(const bf16x8*)(Qb + (ntl * 32 + r) * 136 + ks * 16 + h * 8);
#pragma unroll
    for (int mv = 0; mv < 2; mv++) {
      const bf16x8 a = *(const bf16x8*)(Ss + ((vh * 2 + mv) * 32 + r) * 136 + ks * 16 + h * 8);
      o[mv] = MFMA(a, b, o[mv]);
    }
  }
  __syncthreads();
#pragma unroll
  for (int mv = 0; mv < 2; mv++)
#pragma unroll
    for (int g = 0; g < 4; g++)
      *(float4*)(T + (ntl * 32 + r) * 132 + (vh * 2 + mv) * 32 + 8 * g + 4 * h) = make_float4(o[mv][4 * g], o[mv][4 * g + 1], o[mv][4 * g + 2], o[mv][4 * g + 3]);
  __syncthreads();
  {
    const int t = tid >> 2, c0 = (tid & 3) * 32;
    const long grow = (t0 + t) * 1024 + hd * 128 + c0;
    float x[32];
    float ss = 0.f;
#pragma unroll
    for (int j = 0; j < 8; j++) {
      const float4 tv = *(const float4*)(T + t * 132 + c0 + 4 * j);
      const float4 ov = *(const float4*)(oi + grow + 4 * j);
      x[4 * j] = tv.x + ov.x; x[4 * j + 1] = tv.y + ov.y; x[4 * j + 2] = tv.z + ov.z; x[4 * j + 3] = tv.w + ov.w;
      ss += x[4 * j] * x[4 * j] + x[4 * j + 1] * x[4 * j + 1] + x[4 * j + 2] * x[4 * j + 2] + x[4 * j + 3] * x[4 * j + 3];
    }
    ss += __shfl_xor(ss, 1);
    ss += __shfl_xor(ss, 2);
    const float rsn = rsqrtf(ss * (1.f / 128.f) + EPS);
#pragma unroll
    for (int j = 0; j < 4; j++) {
      const uint4 gg = *(const uint4*)(gs + grow + 8 * j);
      const float4 ga = *(const float4*)(gon + c0 + 8 * j), gb = *(const float4*)(gon + c0 + 8 * j + 4);
      uint4 ov;
      ov.x = pack2(x[8 * j] * rsn * ga.x * bf2f((u16)(gg.x & 0xffff)), x[8 * j + 1] * rsn * ga.y * bf2f((u16)(gg.x >> 16)));
      ov.y = pack2(x[8 * j + 2] * rsn * ga.z * bf2f((u16)(gg.y & 0xffff)), x[8 * j + 3] * rsn * ga.w * bf2f((u16)(gg.y >> 16)));
      ov.z = pack2(x[8 * j + 4] * rsn * gb.x * bf2f((u16)(gg.z & 0xffff)), x[8 * j + 5] * rsn * gb.y * bf2f((u16)(gg.z >> 16)));
      ov.w = pack2(x[8 * j + 6] * rsn * gb.z * bf2f((u16)(gg.w & 0xffff)), x[8 * j + 7] * rsn * gb.w * bf2f((u16)(gg.w >> 16)));
      *(uint4*)(qb + grow + 8 * j) = ov;
    }
  }
}

template <class AL, class BL, class EP>
DI void gemm_phase(int MT, int NTL, int K, AL al, BL bl, EP ep, char* smem) {
  for (int t = blockIdx.x; t < MT * NTL; t += gridDim.x) {
    const int tm = t % MT, tn = t / MT;
    f32x16 acc[2][2];
    gemm_core(al, bl, tm * 128, tn * 128, K, smem, acc);
    ep(acc, tm * 128, tn * 128);
  }
}

template <class AL, class BL>
DI void gemm_phase_n1024(int K, AL al, BL bl, u16* Y, u16* parts, char* smem) {
  for (int u = blockIdx.x; u < 1024 + 512; u += gridDim.x) {
    f32x16 acc[2][2];
    if (u < 1024) {
      const int tm = u % 144, tn = u / 144;
      gemm_core(al, bl, tm * 128, tn * 128, K, smem, acc);
      epi_bf16_tile(acc, tm * 128, tn * 128, Y + (long)tm * 128 * 1024 + tn * 128, 1024, smem, [=](int m, int n, float v) { return v; });
    } else {
      const int v = u - 1024, t = 1024 + (v >> 2), q = v & 3, tm = t % 144, tn = t / 144;
      const int koff = q * (K / 4);
      gemm_core([=](int m, int k) { return al(m, k + koff); }, [=](int n, int k) { return bl(n, k + koff); },
                tm * 128, tn * 128, K / 4, smem, acc);
      if (q == 0) epi_bf16_tile(acc, tm * 128, tn * 128, Y + (long)tm * 128 * 1024 + tn * 128, 1024, smem, [=](int m, int n, float vv) { return vv; });
      else epi_bf16_tile(acc, tm * 128, tn * 128, parts + (long)(q - 1) * NT * 128 + (long)tm * 128 * 128, 128, smem, [=](int m, int n, float vv) { return vv; });
    }
  }
}
DI void ffn_up_phase(const Params& p, const u16* xb, int ldx, const u16* wupT, u16* hid, char* smem) {
  const float* rs = (const float*)(p.ws + W_RS);
  gemm_phase(NT / 128, 32, 1024,
             [=](int m, int k) { return xb + (long)m * ldx + k; },
             [=](int n, int k) { return wupT + (long)n * 1024 + k; },
             [=](const f32x16 (&acc)[2][2], int m0, int n0) {
               epi_bf16_tile(acc, m0, n0, hid + (long)m0 * 4096 + n0, 4096, smem, [=](int m, int n, float v) {
                 const float a = fmaxf(v * rs[m], 0.f);
                 return a * a;
               });
             }, smem);
}
DI void ffn_down_phase(const u16* hid, const u16* wdownT, u16* Y, u16* parts, char* smem) {
  gemm_phase_n1024(4096,
                   [=](int m, int k) { return hid + (long)m * 4096 + k; },
                   [=](int n, int k) { return wdownT + (long)n * 4096 + k; }, Y, parts, smem);
}

__global__ void __launch_bounds__(256, 2) fwd_megakernel(Params p) {
  __shared__ __attribute__((aligned(16))) char smem[SMEM_TOTAL];
  unsigned* bar = (unsigned*)launder(p.ws);
  unsigned* qcnt = (unsigned*)(launder(p.ws) + W_QCNT);
  if (threadIdx.x < 4) ((volatile unsigned*)(smem + SMEM_MAIN))[threadIdx.x] = 0u;
  __syncthreads();
  (void)xcd_barrier_post(bar, (volatile LAS unsigned*)(smem + SMEM_MAIN));
#define GRID_BARRIER() do { XcdBarrier b_; b_.bar = (unsigned*)p.ws; b_.x = xb_xcc_id(); b_.st = (volatile LAS unsigned*)(smem + SMEM_MAIN); xcd_barrier(b_); } while (0)

  convert_weight(p.in[I_WIN0], 1024, 1216, 1280, p.in[I_LMPRE], (u16*)(launder(p.ws) + W_IN0T), smem);
  convert_weight(p.in[I_WUQ], 384, 1536, 1536, p.in[I_QNORM], (u16*)(launder(p.ws) + W_UQT), smem, 320);
  convert_weight(p.in[I_WUK], 256, 1024, 1024, nullptr, (u16*)(launder(p.ws) + W_UKT), smem, 464);
  convert_weight(p.in[I_WUV], 256, 1024, 1024, nullptr, (u16*)(launder(p.ws) + W_UVT), smem, 16);
  convert_weight(p.in[I_WOUT0], 1536, 1024, 1024, nullptr, (u16*)(launder(p.ws) + W_OUT0T), smem, 80);
  convert_weight(p.in[I_WMEMKV], 1024, 1024, 1024, p.in[I_MEMNORM], (u16*)(launder(p.ws) + W_MEMT), smem, 464);
  convert_weight(p.in[I_WMEMKV] + 1024 * 1024, 1024, 1024, 1024, p.in[I_MEMNORM] + 1024, (u16*)(launder(p.ws) + W_MEMT) + 1024 * 1024, smem, 208);
  convert_mem_cache(p, 0, (u16*)(launder(p.ws) + W_MEMKS0), (u16*)(launder(p.ws) + W_MEMVTS0), smem);
  {
    const int tid = opaque_tid(), lane = tid & 63, wv = tid >> 6;
    float* ct = (float*)(launder(p.ws) + W_ROPE);
    float* st = ct + 16384 * 32;
    for (long i = (long)blockIdx.x * 256 + tid; i < 16384L * 32; i += (long)gridDim.x * 256) {
      const int pos = (int)(i >> 5), j = (int)(i & 31);
      const double ang = (double)pos * p.inv_freq[j];
      const double k = rint(ang * 0.15915494309189535);
      const float rr = (float)(ang - k * 6.283185307179586);
      ct[i] = cosf(rr); st[i] = sinf(rr);
    }
    float* rs = (float*)(launder(p.ws) + W_RS);
    float* rsmem = (float*)(launder(p.ws) + W_RSMEM);
    float* y = p.out + O_Y;
    u16* xb0 = (u16*)(launder(p.ws) + W_XB0);
    for (int t = blockIdx.x * 4 + wv; t < NT; t += gridDim.x * 4) {
      const float* xr = xrow(p, t);
      float ss = 0.f;
#pragma unroll
      for (int j = 0; j < 4; j++) {
        const float4 v = ld_nt4(xr + j * 256 + lane * 4);
        ss += v.x * v.x + v.y * v.y + v.z * v.z + v.w * v.w;
        uint2 o; o.x = pack2(v.x, v.y); o.y = pack2(v.z, v.w);
        *(uint2*)(xb0 + (long)t * 1024 + j * 256 + lane * 4) = o;
      }
      ss = wave_sum(ss);
      if (lane == 0) rs[t] = rsqrtf(ss * (1.f / 1024.f) + EPS);
    }
    u16* memb = (u16*)(launder(p.ws) + W_MEMB);
    for (int t = blockIdx.x * 4 + wv; t < 256; t += gridDim.x * 4) {
      const float* xr = p.in[I_MEMP] + (long)t * 1024;
      float ss = 0.f;
#pragma unroll
      for (int j = 0; j < 4; j++) {
        const float4 v = ld_nt4(xr + j * 256 + lane * 4);
        ss += v.x * v.x + v.y * v.y + v.z * v.z + v.w * v.w;
        uint2 o; o.x = pack2(v.x, v.y); o.y = pack2(v.z, v.w);
        *(uint2*)(memb + (long)t * 1024 + j * 256 + lane * 4) = o;
      }
      ss = wave_sum(ss);
      if (lane == 0) rsmem[t] = rsqrtf(ss * (1.f / 1024.f) + EPS);
    }
    u16* latall = (u16*)(launder(p.ws) + W_LATALL);
    u16* krall = (u16*)(launder(p.ws) + W_KRALL);
    for (long i = (long)blockIdx.x * 256 + tid; i < 32L * 1024 * 64; i += (long)gridDim.x * 256) {
      const long row = i >> 6; const int c4 = (int)(i & 63);
      const int b = (int)(row >> 10), j = (int)(row & 1023);
      const float4 v = ld_nt4(p.in[I_CLAT] + row * 256 + c4 * 4);
      uint2 o; o.x = pack2(v.x, v.y); o.y = pack2(v.z, v.w);
      *(uint2*)(latall + ((long)NP + b * 1088 + j) * 256 + c4 * 4) = o;
    }
    for (long i = (long)blockIdx.x * 256 + tid; i < 32L * 1024 * 16; i += (long)gridDim.x * 256) {
      const long row = i >> 4; const int c4 = (int)(i & 15);
      const int b = (int)(row >> 10), j = (int)(row & 1023);
      const float4 v = ld_nt4(p.in[I_CKR] + row * 64 + c4 * 4);
      uint2 o; o.x = pack2(v.x, v.y); o.y = pack2(v.z, v.w);
      *(uint2*)(krall + ((long)NP + b * 1088 + j) * 64 + c4 * 4) = o;
    }
    float* lbv = (float*)(launder(p.ws) + W_LBV);
    for (int i = blockIdx.x * 256 + tid; i < 1024; i += gridDim.x * 256)
      lbv[i] = 1.f / (1.f + expf(p.in[I_LB][i] - p.in[I_LB][1024 + i]));
  }
  if (p.never) cg::this_grid().sync();
  GRID_BARRIER();

  {
    const u16* memb = (const u16*)(launder(p.ws) + W_MEMB);
    const u16* wmemT = (const u16*)(launder(p.ws) + W_MEMT);
    const u16* xb0 = (const u16*)(launder(p.ws) + W_XB0);
    const u16* win0T = (const u16*)(launder(p.ws) + W_IN0T);
    u16* P0b = (u16*)(launder(p.ws) + W_P0F);
    u16* memk_p = (u16*)(launder(p.ws) + W_MEMKP);
    u16* memvT_p = (u16*)(launder(p.ws) + W_MEMVTP);
    float* out = p.out;
    const float* rs = (const float*)(launder(p.ws) + W_RS);
    const float* rsmem = (const float*)(launder(p.ws) + W_RSMEM);
    const int n_mem = 2 * 2 * 8, n_proj = (NT / 128) * 10;
    for (int t = blockIdx.x; t < n_mem + n_proj; t += gridDim.x) {
      f32x16 acc[2][2];
      if (t < n_mem) {
        const int l = t >> 4, tm = (t >> 3) & 1, tn = t & 7;
        const u16* wl = wmemT + (long)l * 1024 * 1024;
        gemm_core([=](int m, int k) { return memb + (long)m * 1024 + k; },
                  [=](int n, int k) { return wl + (long)n * 1024 + k; }, tm * 128, tn * 128, 1024, smem, acc);
        epi_each(acc, tm * 128, tn * 128, [=](int m, int n, float v) {
          v *= rsmem[m];
          if (n < 512) {
            out[O_MKP + ((long)l * 256 + m) * 512 + n] = v;
            memk_p[((long)l * 256 + m) * 512 + n] = f2bf(v);
          } else {
            const int e = n - 512;
            out[O_MVP + ((long)l * 256 + m) * 512 + e] = v;
            memvT_p[((long)l * 512 + e) * 256 + m] = f2bf(v);
          }
        });
      } else {
        const int tt = t - n_mem, tm = tt % (NT / 128), tn = tt / (NT / 128);
        gemm_core([=](int m, int k) { return xb0 + (long)m * 1024 + k; },
                  [=](int n, int k) { return win0T + (long)n * 1024 + k; }, tm * 128, tn * 128, 1024, smem, acc);
        epi_bf16_tile(acc, tm * 128, tn * 128, P0b + (long)tm * 128 * 1280 + tn * 128, 1280, smem, [=](int m, int n, float v) { return v * rs[m]; });
      }
    }
  }
  GRID_BARRIER();

  {
    const u16* P0b = (const u16*)(launder(p.ws) + W_P0F);
    const float* ct = (const float*)(launder(p.ws) + W_ROPE);
    const float* st = ct + 16384 * 32;
    u16* cqn = (u16*)(launder(p.ws) + W_CQN);
    u16* xq = (u16*)(launder(p.ws) + W_XQ0);
    u16* latall = (u16*)(launder(p.ws) + W_LATALL);
    u16* krall = (u16*)(launder(p.ws) + W_KRALL);
    const float* gkv = p.in[I_KVNORM];
    const int tid = opaque_tid(), lane = tid & 63, wv = tid >> 6;
    for (int t = blockIdx.x * 4 + wv; t < NT; t += gridDim.x * 4) {
      const u16* pr = P0b + (long)t * 1280;
      const int pos = tok_pos(t);
      const long kv = tok_kv(t);
      float* lat_o = (t < NP) ? p.out + O_LATP + (long)t * 256 : p.out + O_LATS + (long)(t - NP) * 256;
      float* kr_o = (t < NP) ? p.out + O_KRP + (long)t * 64 : p.out + O_KRS + (long)(t - NP) * 64;
      float cq[6]; float ss = 0.f;
#pragma unroll
      for (int j = 0; j < 6; j++) { cq[j] = bf2f(pr[j * 64 + lane]); ss += cq[j] * cq[j]; }
      ss = wave_sum(ss);
      float r = rsqrtf(ss * (1.f / 384.f) + EPS);
#pragma unroll
      for (int j = 0; j < 6; j++) cqn[(long)t * 384 + j * 64 + lane] = f2bf(cq[j] * r);
      float ck[4]; ss = 0.f;
#pragma unroll
      for (int j = 0; j < 4; j++) { ck[j] = bf2f(pr[384 + j * 64 + lane]); ss += ck[j] * ck[j]; }
      ss = wave_sum(ss);
      r = rsqrtf(ss * (1.f / 256.f) + EPS);
#pragma unroll
      for (int j = 0; j < 4; j++) {
        const float v = ck[j] * r * gkv[j * 64 + lane];
        lat_o[j * 64 + lane] = v;
        latall[kv * 256 + j * 64 + lane] = f2bf(v);
      }
      {
        const float xv = bf2f(pr[640 + lane]);
        const float pv = __shfl_xor(xv, 32);
        const int i = lane & 31;
        const float c = ct[pos * 32 + i], s = st[pos * 32 + i];
        const float v = (lane < 32) ? xv * c - pv * s : xv * c + pv * s;
        kr_o[lane] = v;
        krall[kv * 64 + lane] = f2bf(v);
      }
#pragma unroll
      for (int j = 0; j < 8; j++) xq[(long)t * 512 + j * 64 + lane] = f2bf(bf2f(pr[704 + j * 64 + lane]) * XSCALE);
    }
  }
  GRID_BARRIER();

  for (int g = 0; g < 2; g++) {
    {
      const u16* cqn = (const u16*)(launder(p.ws) + W_CQN);
      const u16* wuqT = (const u16*)(launder(p.ws) + W_UQT);
      const u16* latall = (const u16*)(launder(p.ws) + W_LATALL);
      const u16* lats = latall + (long)NP * 256;
      const u16* wukT = (const u16*)(launder(p.ws) + W_UKT);
      const u16* wuvT = (const u16*)(launder(p.ws) + W_UVT);
      const u16* wukTg = wukT + (long)g * 512 * 256;
      const u16* wuvTg = wuvT + (long)g * 512 * 256;
      const float* ct = (const float*)(launder(p.ws) + W_ROPE);
      const float* st = ct + 16384 * 32;
      u16* Q = (u16*)(launder(p.ws) + W_Q);
      u16* knp = (u16*)(launder(p.ws) + W_KNP);
      u16* vtp = (u16*)(launder(p.ws) + W_VTP);
      u16* kns = (u16*)(launder(p.ws) + W_KNS);
      u16* vts = (u16*)(launder(p.ws) + W_VTS);
      const int n_q = (g == 0) ? (NT / 128) * 12 : 0;
      const int n_kp = (g == 0) ? (NP / 128) * 8 : 0, n_vp = n_kp;
      const int n_ks = (NSKV / 128) * 4, n_vs = n_ks;
      const int e1 = n_q, e2 = e1 + n_kp, e3 = e2 + n_vp, e4 = e3 + n_ks, e5 = e4 + n_vs;
      for (int t = blockIdx.x; t < e5; t += gridDim.x) {
        f32x16 acc[2][2];
        if (t < e1) {
          const int tm = t % (NT / 128), tn = t / (NT / 128), m0 = tm * 128, n0 = tn * 128;
          gemm_core([=](int m, int k) { return cqn + (long)m * 384 + k; },
                    [=](int n, int k) { return wuqT + (long)n * 384 + k; }, m0, n0, 384, smem, acc);
          const int tid = opaque_tid(), lane = tid & 63, wv = tid >> 6;
          const int wm = wv >> 1, wn = wv & 1, h = lane >> 5, r = lane & 31;
          const int nw0 = n0 + wn * 64;
          const bool is_rope = (nw0 % 192) == 128;
          if (is_rope) {
#pragma unroll
            for (int mt = 0; mt < 2; mt++)
#pragma unroll
              for (int i = 0; i < 16; i++) {
                const int m = m0 + wm * 64 + mt * 32 + crow(i, h);
                const float v0 = acc[mt][0][i], v1 = acc[mt][1][i];
                const int pos = tok_pos(m);
                const float c = ct[pos * 32 + r], s = st[pos * 32 + r];
                Q[(long)m * 1536 + nw0 + r] = f2bf((v0 * c - v1 * s) * QSCALE);
                Q[(long)m * 1536 + nw0 + 32 + r] = f2bf((v1 * c + v0 * s) * QSCALE);
              }
          } else {
#pragma unroll
            for (int mt = 0; mt < 2; mt++)
#pragma unroll
              for (int i = 0; i < 16; i++) {
                const int m = m0 + wm * 64 + mt * 32 + crow(i, h);
                Q[(long)m * 1536 + nw0 + r] = f2bf(acc[mt][0][i] * QSCALE);
                Q[(long)m * 1536 + nw0 + 32 + r] = f2bf(acc[mt][1][i] * QSCALE);
              }
          }
        } else if (t < e2) {
          const int tt = t - e1, tm = tt % (NP / 128), tn = tt / (NP / 128);
          gemm_core([=](int m, int k) { return latall + (long)m * 256 + k; },
                    [=](int n, int k) { return wukT + (long)n * 256 + k; }, tm * 128, tn * 128, 256, smem, acc);
          epi_bf16_tile(acc, tm * 128, tn * 128, knp + ((long)tn * NP + tm * 128) * 128, 128, smem, [=](int m, int n, float v) { return v; });
        } else if (t < e3) {
          const int tt = t - e2, tn = tt % (NP / 128), tm = tt / (NP / 128);
          gemm_core([=](int m, int k) { return wuvT + (long)m * 256 + k; },
                    [=](int n, int k) { return latall + (long)n * 256 + k; }, tm * 128, tn * 128, 256, smem, acc);
          epi_bf16_vtile(acc, vtp + ((long)tm * (NP / 64) + 2 * tn) * 8192, smem, [=](float v) { return v; });
        } else if (t < e4) {
          const int tt = t - e3, tm = tt % (NSKV / 128), tn = tt / (NSKV / 128);
          gemm_core([=](int m, int k) { return lats + (long)m * 256 + k; },
                    [=](int n, int k) { return wukTg + (long)n * 256 + k; }, tm * 128, tn * 128, 256, smem, acc);
          epi_bf16_tile(acc, tm * 128, tn * 128, kns + ((long)tn * NSKV + tm * 128) * 128, 128, smem, [=](int m, int n, float v) { return v; });
        } else {
          const int tt = t - e4, tn = tt % (NSKV / 128), tm = tt / (NSKV / 128);
          gemm_core([=](int m, int k) { return wuvTg + (long)m * 256 + k; },
                    [=](int n, int k) { return lats + (long)n * 256 + k; }, tm * 128, tn * 128, 256, smem, acc);
          epi_bf16_vtile(acc, vts + ((long)tm * (NSKV / 64) + 2 * tn) * 8192, smem, [=](float v) { return v; });
        }
      }
    }
    GRID_BARRIER();
    attn_phase_l0(p, g, qcnt + g, smem);
    GRID_BARRIER();
  }

  {
    const u16* Q = (const u16*)(launder(p.ws) + W_Q);
    const u16* xq = (const u16*)(launder(p.ws) + W_XQ0);
    const u16* woutT = (const u16*)(launder(p.ws) + W_OUT0T);
    u16* Y = (u16*)(launder(p.ws) + W_Y7);
    gemm_phase_n1024(1536,
               [=](int m, int k) { return (k < 1024) ? Q + (long)m * 1536 + (k >> 7) * 192 + (k & 127) : xq + (long)m * 512 + (k - 1024); },
               [=](int n, int k) { return woutT + (long)n * 1536 + k; }, Y, (u16*)(launder(p.ws) + W_PART7), smem);
  }
  GRID_BARRIER();
  rowwise_residual(p, (const u16*)(launder(p.ws) + W_Y7), p.in[I_LMPOST], 0, (const u16*)(launder(p.ws) + W_PART7));
  convert_weight(p.in[I_WUP], 1024, 4096, 4096, p.in[I_LFPRE], (u16*)(launder(p.ws) + W_UP0T), smem);
  convert_weight(p.in[I_WDOWN], 4096, 1024, 1024, nullptr, (u16*)(launder(p.ws) + W_DOWN0T), smem);
  GRID_BARRIER();
  ffn_up_phase(p, xres_base(p), XR_LD, (const u16*)(launder(p.ws) + W_UP0T), (u16*)(launder(p.ws) + W_HID0), smem);
  GRID_BARRIER();
  ffn_down_phase((const u16*)(launder(p.ws) + W_HID0), (const u16*)(launder(p.ws) + W_DOWN0T), (u16*)(launder(p.ws) + W_Y10), (u16*)(launder(p.ws) + W_PART10), smem);
  GRID_BARRIER();
  rowwise_residual(p, (const u16*)(launder(p.ws) + W_Y10), p.in[I_LFPOST], 1, (const u16*)(launder(p.ws) + W_PART10));
  convert_weight(p.in[I_WIN1], 1024, 4608, 4608, p.in[I_LMPRE] + 1024, (u16*)(launder(p.ws) + W_IN1T), smem);
  convert_weight(p.in[I_WOUT1], 1536, 1024, 1024, nullptr, (u16*)(launder(p.ws) + W_OUT1T), smem, 128);
  GRID_BARRIER();
  {
    const u16* xb1 = xres_base(p);
    const u16* win1T = (const u16*)(launder(p.ws) + W_IN1T);
    u16* qs = (u16*)(launder(p.ws) + W_QS);
    float* f = (float*)(launder(p.ws) + W_F);
    u16* vv = (u16*)(launder(p.ws) + W_V);
    u16* gs = (u16*)(launder(p.ws) + W_GS);
    u16* xq1 = (u16*)(launder(p.ws) + W_XQ1);
    const float* rs = (const float*)(launder(p.ws) + W_RS);
    gemm_phase(NT / 128, 36, 1024,
               [=](int m, int k) { return xb1 + (long)m * XR_LD + k; },
               [=](int n, int k) { return win1T + (long)n * 1024 + k; },
               [=](const f32x16 (&acc)[2][2], int m0, int n0) {
                 const int cb = n0 >> 10;
                 if (cb == 0) epi_bf16_tile(acc, m0, n0, qs + (long)m0 * 1024 + n0, 1024, smem, [=](int m, int n, float v) { return siluf_(v * rs[m]); });
                 else if (cb == 1) epi_each(acc, m0, n0, [=](int m, int n, float v) { f[(long)m * 1024 + (n - 1024)] = v * rs[m]; });
                 else if (cb == 2) epi_bf16_tile(acc, m0, n0, vv + (long)m0 * 1024 + (n0 - 2048), 1024, smem, [=](int m, int n, float v) { return v * rs[m]; });
                 else if (cb == 3) epi_bf16_tile(acc, m0, n0, gs + (long)m0 * 1024 + (n0 - 3072), 1024, smem, [=](int m, int n, float v) { return siluf_(v * rs[m]); });
                 else epi_bf16_tile(acc, m0, n0, xq1 + (long)m0 * 512 + (n0 - 4096), 512, smem, [=](int m, int n, float v) { return v * rs[m] * XSCALE; });
               }, smem);
  }
  GRID_BARRIER();
  for (int it = blockIdx.x; it < NCHUNK * 8; it += gridDim.x) hgrn_chunk_item(p, it >> 3, it & 7, smem);
  GRID_BARRIER();
  hgrn_scan_phase(p, smem);
  __syncthreads();
  convert_mem_cache(p, 1, (u16*)(launder(p.ws) + W_MEMKS1), (u16*)(launder(p.ws) + W_MEMVTS1), smem);
  GRID_BARRIER();
  for (int it = blockIdx.x; it < NCHUNK * 8; it += gridDim.x) hgrn_final_item(p, it >> 3, it & 7, smem);
  cross_phase_l1(p, qcnt + 2, smem);
  GRID_BARRIER();
  {
    const u16* mix = (const u16*)(launder(p.ws) + W_QS);
    const u16* xq1 = (const u16*)(launder(p.ws) + W_XQ1);
    const u16* woutT = (const u16*)(launder(p.ws) + W_OUT1T);
    u16* Y = (u16*)(launder(p.ws) + W_Y16);
    gemm_phase_n1024(1536,
               [=](int m, int k) { return (k < 1024) ? mix + (long)m * 1024 + k : xq1 + (long)m * 512 + (k - 1024); },
               [=](int n, int k) { return woutT + (long)n * 1536 + k; }, Y, (u16*)(launder(p.ws) + W_PART16), smem);
  }
  GRID_BARRIER();
  rowwise_residual(p, (const u16*)(launder(p.ws) + W_Y16), p.in[I_LMPOST] + 1024, 1, (const u16*)(launder(p.ws) + W_PART16));
  convert_weight(p.in[I_WUP] + 1024L * 4096, 1024, 4096, 4096, p.in[I_LFPRE] + 1024, (u16*)(launder(p.ws) + W_UP1T), smem);
  convert_weight(p.in[I_WDOWN] + 4096L * 1024, 4096, 1024, 1024, nullptr, (u16*)(launder(p.ws) + W_DOWN1T), smem);
  GRID_BARRIER();
  ffn_up_phase(p, xres_base(p), XR_LD, (const u16*)(launder(p.ws) + W_UP1T), (u16*)(launder(p.ws) + W_HID1), smem);
  GRID_BARRIER();
  ffn_down_phase((const u16*)(launder(p.ws) + W_HID1), (const u16*)(launder(p.ws) + W_DOWN1T), (u16*)(launder(p.ws) + W_Y19), (u16*)(launder(p.ws) + W_PART19), smem);
  GRID_BARRIER();
  rowwise_residual(p, (const u16*)(launder(p.ws) + W_Y19), p.in[I_LFPOST] + 1024, 2, (const u16*)(launder(p.ws) + W_PART19));
}

extern "C" void kernel_launch(void* const* d_in, const int* in_sizes, int n_in, void* d_out, int out_size,
                              void* d_ws, size_t ws_size, hipStream_t stream) {
  static int grid_blocks = 0;
  if (!grid_blocks) {
    int dev = 0, cus = 0, per_cu = 0;
    (void)hipGetDevice(&dev);
    (void)hipDeviceGetAttribute(&cus, hipDeviceAttributeMultiprocessorCount, dev);
    (void)hipOccupancyMaxActiveBlocksPerMultiprocessor(&per_cu, fwd_megakernel, 256, 0);
    if (per_cu > 2) per_cu = 2;
    if (per_cu < 1) per_cu = 1;
    grid_blocks = cus * per_cu;
  }
  if (ws_size < WS_NEED || n_in < 27) { fprintf(stderr, "workspace too small: %zu < %zu\n", ws_size, WS_NEED); return; }
  Params p;
  memset(&p, 0, sizeof(p));
  for (int i = 0; i < 27; i++) p.in[i] = (const float*)d_in[i];
  p.out = (float*)d_out;
  p.ws = (char*)d_ws;
  for (int i = 0; i < 32; i++) p.inv_freq[i] = pow(10000.0, -(double)i / 32.0);
  p.never = 0;
  (void)hipMemsetAsync(d_ws, 0, 65536, stream);
  void* args[] = {&p};
  hipError_t e = hipLaunchCooperativeKernel((void*)fwd_megakernel, dim3(grid_blocks), dim3(256), args, 0, stream);
  if (e != hipSuccess) fprintf(stderr, "cooperative launch failed: %s (grid %d)\n", hipGetErrorString(e), grid_blocks);
}
```

```cpp
#include <hip/hip_runtime.h>
#include <hip/hip_cooperative_groups.h>
#include <stdint.h>
#include <math.h>
#include <stdio.h>
#include <string.h>
namespace cg = cooperative_groups;

#define DI __device__ __forceinline__
typedef unsigned short u16;
typedef __attribute__((ext_vector_type(8))) short bf16x8;
typedef __attribute__((ext_vector_type(4))) short s16x4;
typedef __attribute__((ext_vector_type(16))) float f32x16;
#define MFMA(a, b, c) __builtin_amdgcn_mfma_f32_32x32x16_bf16((a), (b), (c), 0, 0, 0)

constexpr int NP = 16384, NS = 2048, NT = NP + NS, NKV = NP + 32 * 1088;
constexpr int NCHUNK = NT / 64;
constexpr float EPS = 1e-6f;
constexpr float LOG2E = 1.4426950408889634f;
constexpr float QSCALE = 0.07216878364870322f * LOG2E;
constexpr float XSCALE = 0.08838834764831845f * LOG2E;

constexpr long O_Y = 0, O_LATP = 18874368, O_KRP = 23068672, O_HGP = 24117248, O_MKP = 24248320,
               O_MVP = 24510464, O_LATS = 24772608, O_KRS = 25296896, O_HGS = 25427968;

constexpr size_t MiB = 1048576;
constexpr size_t WS_NEED = 304 * MiB;
constexpr size_t W_QCNT = 16384;
constexpr size_t W_RS = 0x10000, W_RSMEM = 0x30000, W_LBV = 0x31000, W_DECAY = 0x40000;
constexpr size_t W_MEMKP = 3 * MiB, W_MEMVTP = 3 * MiB + MiB / 2;
constexpr size_t W_IN0T = 4 * MiB, W_UQT = 6 * MiB + MiB / 2, W_UKT = 7 * MiB + 3 * MiB / 4, W_UVT = 8 * MiB + MiB / 4,
                 W_OUT0T = 8 * MiB + 3 * MiB / 4, W_MEMT = 12 * MiB, W_ROPE = 16 * MiB, W_MEMB = 20 * MiB,
                 W_XB0 = 21 * MiB, W_LATALL = 57 * MiB, W_KRALL = 82 * MiB, W_MEMKS0 = 89 * MiB, W_MEMVTS0 = 97 * MiB,
                 W_P0F = 105 * MiB, W_CQN = 281 * MiB, W_XQ0 = 209 * MiB, W_Q = 227 * MiB, W_KNP = 105 * MiB,
                 W_VTP = 137 * MiB, W_KNS = 169 * MiB, W_VTS = 21 * MiB, W_Y7 = 105 * MiB, W_UP0T = 220 * MiB, W_DOWN0T = 228 * MiB, W_HID0 = 76 * MiB,
                 W_Y10 = 4 * MiB;
constexpr size_t W_XB1 = 256 * MiB, W_IN1T = 292 * MiB, W_OUT1T = 301 * MiB, W_QS = 4 * MiB, W_F = 40 * MiB,
                 W_V = 112 * MiB, W_GS = 148 * MiB, W_XQ1 = 184 * MiB, W_U = 202 * MiB, W_MEMKS1 = 112 * MiB,
                 W_MEMVTS1 = 120 * MiB, W_Y16 = 40 * MiB, W_XB2 = 4 * MiB, W_UP1T = 112 * MiB, W_DOWN1T = 120 * MiB,
                 W_HID1 = 128 * MiB, W_Y19 = 40 * MiB;
constexpr size_t W_PART7 = 177 * MiB, W_PART10 = 236 * MiB, W_PART16 = 148 * MiB, W_PART19 = 272 * MiB;

struct Params {
  const float* in[27];
  float* out;
  char* ws;
  double inv_freq[32];
  int never;
  int pad;
};
enum { I_XP = 0, I_XS, I_CLAT, I_CKR, I_CHS, I_CMK, I_CMV, I_MEMP, I_LMPRE, I_LMPOST, I_LFPRE, I_LFPOST, I_MEMNORM,
       I_WMEMKV, I_WIN0, I_QNORM, I_KVNORM, I_WUQ, I_WUK, I_WUV, I_WOUT0, I_WIN1, I_LB, I_ONORM, I_WOUT1, I_WUP, I_WDOWN };

typedef __bf16 bf16v2_t __attribute__((ext_vector_type(2)));
typedef float f32v2_t __attribute__((ext_vector_type(2)));
DI unsigned pack2(float a, float b) { f32v2_t v = {a, b}; return __builtin_bit_cast(unsigned, __builtin_convertvector(v, bf16v2_t)); }
DI u16 f2bf(float x) { return (u16)(pack2(x, 0.f) & 0xffffu); }
DI float bf2f(u16 h) { return __uint_as_float(((unsigned)h) << 16); }
typedef float f32x4n __attribute__((ext_vector_type(4)));
DI float4 ld_nt4(const float* q) { const f32x4n v = __builtin_nontemporal_load((const f32x4n*)q); return make_float4(v.x, v.y, v.z, v.w); }
DI float wave_sum(float v) {
#pragma unroll
  for (int o = 32; o >= 1; o >>= 1) v += __shfl_xor(v, o);
  return v;
}
DI char* launder(char* q) { return q; }
DI int opaque_tid() { int t = threadIdx.x; asm volatile("" : "+v"(t)); return t; }
DI int crow(int i, int h) { return (i & 3) + 8 * (i >> 2) + 4 * h; }
DI float sigmoidf_(float x) { return __builtin_amdgcn_rcpf(1.f + __expf(-x)); }
DI float siluf_(float x) { return x * __builtin_amdgcn_rcpf(1.f + __expf(-x)); }

#define XB_TMO      128
#define XB_XCNT(j)  (256  + 64 * (j))
#define XB_XSUB(j)  (1280 + 64 * (j))
#define XB_XGEN(j)  (2304 + 64 * (j))
#define XB_TOP      3328
#define XB_TOPGEN   3392
#define XCD_BAR_WORDS 3456
#define XB_SPIN_CAP (1u << 23)
#define LAS __attribute__((address_space(3)))
DI unsigned xb_ld(unsigned* p) { return __hip_atomic_load(p, __ATOMIC_RELAXED, __HIP_MEMORY_SCOPE_AGENT); }
DI unsigned xb_add(unsigned* p, unsigned v) { return __hip_atomic_fetch_add(p, v, __ATOMIC_RELAXED, __HIP_MEMORY_SCOPE_AGENT); }
DI unsigned xb_xcc_id() { return (unsigned)__builtin_amdgcn_s_getreg((3 << 11) | 20) & 0xFu; }
#define XB_SPIN(cond, bar) do { unsigned _sp = 0; while (cond) { __builtin_amdgcn_s_sleep(1); \
    if ((++_sp & 255u) == 0u) { if (xb_ld(&(bar)[XB_TMO])) break; if (_sp > XB_SPIN_CAP) { atomicAdd(&(bar)[XB_TMO], 1u); break; } } } } while (0)
struct XcdBarrier { unsigned* bar; unsigned x; volatile LAS unsigned* st; };
DI XcdBarrier xcd_barrier_post(unsigned* bar, volatile LAS unsigned* st) {
  XcdBarrier b; b.bar = bar; b.x = xb_xcc_id(); b.st = st;
  if (threadIdx.x == 0) (void)xb_add(&bar[XB_XCNT(b.x)], 1u);
  return b;
}
DI void xcd_barrier_complete(unsigned* bar, unsigned x, unsigned& nloc, unsigned& nx) {
  const unsigned G = gridDim.x * gridDim.y * gridDim.z;
  unsigned sum, cnt, mine, sp = 0u;
  for (;;) {
    sum = 0u; cnt = 0u; mine = 0u;
#pragma unroll
    for (unsigned j = 0; j < 16; ++j) { const unsigned c = xb_ld(&bar[XB_XCNT(j)]); sum += c; cnt += (c > 0u) ? 1u : 0u; mine = (j == x) ? c : mine; }
    if (sum == G) break;
    __builtin_amdgcn_s_sleep(1);
    if ((++sp & 255u) == 0u) { if (xb_ld(&bar[XB_TMO])) break; if (sp > XB_SPIN_CAP) { atomicAdd(&bar[XB_TMO], 1u); break; } }
  }
  nloc = mine > 0u ? mine : 1u; nx = cnt > 0u ? cnt : 1u;
}
DI void xcd_barrier(const XcdBarrier& b) {
  asm volatile("s_waitcnt vmcnt(0)" ::: "memory");
  __syncthreads();
  if (threadIdx.x == 0) {
    unsigned* bar = b.bar;
    __builtin_amdgcn_s_waitcnt(0);
    unsigned nloc = b.st[0], nx = b.st[1];
    if (nloc == 0u) { xcd_barrier_complete(bar, b.x, nloc, nx); b.st[0] = nloc; b.st[1] = nx; }
    const unsigned old = xb_add(&bar[XB_XSUB(b.x)], 1u);
    const unsigned gen = old / nloc;
    if (old + 1u == (gen + 1u) * nloc) {
      __builtin_amdgcn_fence(__ATOMIC_RELEASE, "agent");
      asm volatile("s_waitcnt vmcnt(0)" ::: "memory");
      const unsigned og = xb_add(&bar[XB_TOP], 1u);
      const unsigned tg = og / nx;
      if (og + 1u == (tg + 1u) * nx) xb_add(&bar[XB_TOPGEN], 1u);
      else XB_SPIN(xb_ld(&bar[XB_TOPGEN]) == tg, bar);
      __builtin_amdgcn_fence(__ATOMIC_ACQUIRE, "agent");
      xb_add(&bar[XB_XGEN(b.x)], 1u);
      asm volatile("s_waitcnt vmcnt(0)" ::: "memory");
    } else {
      XB_SPIN(xb_ld(&bar[XB_XGEN(b.x)]) == gen, bar);
      __builtin_amdgcn_fence(__ATOMIC_ACQUIRE, "agent");
      asm volatile("s_waitcnt vmcnt(0)" ::: "memory");
    }
  }
  __syncthreads();
}

constexpr int SMEM_MAIN = 73728;
constexpr int SMEM_TOTAL = SMEM_MAIN + 256;

DI void tr_tile(const float* __restrict__ src, long ld_src, int N, const float* __restrict__ gain,
                u16* __restrict__ dst, long ld_dst, int kt, int nt, float* tile  ) {
  const int tid = opaque_tid();
  const bool inside = nt * 64 < N;
  float4 v[4];
#pragma unroll
  for (int j = 0; j < 4; j++) {
    const int idx = tid + 256 * j, r = idx >> 4, c4 = idx & 15;
    v[j] = make_float4(0.f, 0.f, 0.f, 0.f);
    if (inside) {
      v[j] = ld_nt4(src + (long)(kt * 64 + r) * ld_src + nt * 64 + c4 * 4);
      if (gain) { const float g = gain[kt * 64 + r]; v[j].x *= g; v[j].y *= g; v[j].z *= g; v[j].w *= g; }
    }
  }
#pragma unroll
  for (int j = 0; j < 4; j++) {
    const int idx = tid + 256 * j, r = idx >> 4, c4 = idx & 15;
    float* tp = tile + r * 65 + c4 * 4;
    tp[0] = v[j].x; tp[1] = v[j].y; tp[2] = v[j].z; tp[3] = v[j].w;
  }
  __syncthreads();
#pragma unroll
  for (int j = 0; j < 2; j++) {
    const int idx = tid + 256 * j, rn = idx >> 3, ck = idx & 7;
    const float* tp = tile + (ck * 8) * 65 + rn;
    uint4 o;
    o.x = pack2(tp[0], tp[65]); o.y = pack2(tp[2 * 65], tp[3 * 65]); o.z = pack2(tp[4 * 65], tp[5 * 65]); o.w = pack2(tp[6 * 65], tp[7 * 65]);
    *(uint4*)(dst + (long)(nt * 64 + rn) * ld_dst + kt * 64 + ck * 8) = o;
  }
  __syncthreads();
}
DI void convert_weight(const float* src, int K, int N, int Npad, const float* gain, u16* dst, char* smem, int rot = 0) {
  const int nkt = K / 64, nnt = Npad / 64;
  const int b0 = (int)((blockIdx.x + gridDim.x - (unsigned)rot % gridDim.x) % gridDim.x);
  for (int i = b0; i < nkt * nnt; i += gridDim.x) tr_tile(src, N, N, gain, dst, K, i % nkt, i / nkt, (float*)smem);
}
DI void convert_mem_cache(const Params& p, int l, u16* memk_s, u16* memvT_s, char* smem) {
  const float* ck = p.in[I_CMK] + (long)l * 32 * 256 * 512;
  const long n4 = 32L * 256 * 512 / 4;
  const int tid = opaque_tid();
  for (long i = (long)blockIdx.x * 256 + tid; i < n4; i += (long)gridDim.x * 256) {
    const float4 v = ld_nt4(ck + i * 4);
    uint2 o; o.x = pack2(v.x, v.y); o.y = pack2(v.z, v.w);
    ((uint2*)memk_s)[i] = o;
  }
  const float* cv = p.in[I_CMV] + (long)l * 32 * 256 * 512;
  for (int i = blockIdx.x; i < 128 * 8; i += gridDim.x) {
    const int bh = i >> 3, t = i & 7, b = bh >> 2, h = bh & 3;
    tr_tile(cv + (long)b * 256 * 512 + h * 128, 512, 128, nullptr, memvT_s + (long)bh * 128 * 256, 256, t & 3, t >> 2, (float*)smem);
  }
}

template <class AL, class BL>
DI void gemm_core(AL al, BL bl, int m0, int n0, int K, char* smem, f32x16 (&acc)[2][2]) {
  const int tid = opaque_tid(), lane = tid & 63, w = tid >> 6, wm = w >> 1, wn = w & 1;
  u16* As = (u16*)smem;
  u16* Bs = As + 2 * 128 * 72;
  uint4 xa0, xa1, xa2, xa3, xb0, xb1, xb2, xb3, ya0, ya1, ya2, ya3, yb0, yb1, yb2, yb3;
  const int nk = K / 64;
#pragma unroll
  for (int mt = 0; mt < 2; mt++)
#pragma unroll
    for (int nt = 0; nt < 2; nt++)
#pragma unroll
      for (int i = 0; i < 16; i++) acc[mt][nt][i] = 0.f;
  const int srow = tid >> 3, sch = tid & 7;
#define G_LD1(RA, RB, i_, kt_) RA = *(const uint4*)al(m0 + srow + 32 * (i_), (kt_) * 64 + sch * 8); RB = *(const uint4*)bl(n0 + srow + 32 * (i_), (kt_) * 64 + sch * 8)
#define G_LOAD(S, kt_) do { G_LD1(S##a0, S##b0, 0, kt_); G_LD1(S##a1, S##b1, 1, kt_); G_LD1(S##a2, S##b2, 2, kt_); G_LD1(S##a3, S##b3, 3, kt_); } while (0)
#define G_ST1(RA, RB, i_, buf_) *(uint4*)(As + ((buf_) * 128 + srow + 32 * (i_)) * 72 + sch * 8) = RA; *(uint4*)(Bs + ((buf_) * 128 + srow + 32 * (i_)) * 72 + sch * 8) = RB
#define G_STORE(S, buf_) do { G_ST1(S##a0, S##b0, 0, buf_); G_ST1(S##a1, S##b1, 1, buf_); G_ST1(S##a2, S##b2, 2, buf_); G_ST1(S##a3, S##b3, 3, buf_); } while (0)
#define G_FRAG(AF, BF, buf_, ks_) do { \
    const u16* Ab = As + (buf_) * 128 * 72; const u16* Bb = Bs + (buf_) * 128 * 72; \
    AF[0] = *(const bf16x8*)(Ab + (wm * 64 + (lane & 31)) * 72 + (ks_) * 16 + (lane >> 5) * 8); \
    AF[1] = *(const bf16x8*)(Ab + (wm * 64 + 32 + (lane & 31)) * 72 + (ks_) * 16 + (lane >> 5) * 8); \
    BF[0] = *(const bf16x8*)(Bb + (wn * 64 + (lane & 31)) * 72 + (ks_) * 16 + (lane >> 5) * 8); \
    BF[1] = *(const bf16x8*)(Bb + (wn * 64 + 32 + (lane & 31)) * 72 + (ks_) * 16 + (lane >> 5) * 8); } while (0)
#define G_MMA(AF, BF) do { \
    acc[0][0] = MFMA(AF[0], BF[0], acc[0][0]); acc[0][1] = MFMA(AF[0], BF[1], acc[0][1]); \
    acc[1][0] = MFMA(AF[1], BF[0], acc[1][0]); acc[1][1] = MFMA(AF[1], BF[1], acc[1][1]); } while (0)
#define G_STEP(buf_, S, ks_, AF, BF, AN, BN, do_st, do_ld, ktn_) do { \
    if ((ks_) < 3) G_FRAG(AN, BN, buf_, (ks_) + 1); \
    G_MMA(AF, BF); \
    if (do_st) { G_ST1(S##a##ks_, S##b##ks_, ks_, (buf_) ^ 1); } \
    if (do_ld) { G_LD1(S##a##ks_, S##b##ks_, ks_, ktn_); } \
    __builtin_amdgcn_sched_barrier(0); } while (0)
#define G_TILE(buf_, S, do_st, do_ld, ktn_) do { \
    bf16x8 fa0[2], fb0[2], fa1[2], fb1[2]; \
    G_FRAG(fa0, fb0, buf_, 0); \
    G_STEP(buf_, S, 0, fa0, fb0, fa1, fb1, do_st, do_ld, ktn_); \
    G_STEP(buf_, S, 1, fa1, fb1, fa0, fb0, do_st, do_ld, ktn_); \
    G_STEP(buf_, S, 2, fa0, fb0, fa1, fb1, do_st, do_ld, ktn_); \
    G_STEP(buf_, S, 3, fa1, fb1, fa0, fb0, do_st, do_ld, ktn_); } while (0)
  G_LOAD(x, 0);
  G_STORE(x, 0);
  G_LOAD(x, 1);
  G_LOAD(y, (nk > 2) ? 2 : 1);
  __syncthreads();
  for (int kt = 0; kt < nk; kt += 2) {
    G_TILE(0, x, true, (kt + 3 < nk), kt + 3);
    __syncthreads();
    G_TILE(1, y, (kt + 2 < nk), (kt + 4 < nk), kt + 4);
    __syncthreads();
  }
#undef G_LD1
#undef G_ST1
#undef G_LOAD
#undef G_STORE
#undef G_FRAG
#undef G_MMA
#undef G_STEP
#undef G_TILE
}
template <class F>
DI void epi_each(const f32x16 (&acc)[2][2], int m0, int n0, F f) {
  const int tid = opaque_tid(), lane = tid & 63, w = tid >> 6, wm = w >> 1, wn = w & 1, h = lane >> 5;
#pragma unroll
  for (int mt = 0; mt < 2; mt++)
#pragma unroll
    for (int nt = 0; nt < 2; nt++)
#pragma unroll
      for (int i = 0; i < 16; i++)
        f(m0 + wm * 64 + mt * 32 + crow(i, h), n0 + wn * 64 + nt * 32 + (lane & 31), acc[mt][nt][i]);
}

template <class F>
DI void epi_bf16_tile(const f32x16 (&acc)[2][2], int m0, int n0, u16* dst0, long ld, char* smem, F f) {
  const int tid = opaque_tid(), lane = tid & 63, w = tid >> 6, wm = w >> 1, wn = w & 1, h = lane >> 5;
  u16* T = (u16*)smem;
#pragma unroll
  for (int mt = 0; mt < 2; mt++)
#pragma unroll
    for (int nt = 0; nt < 2; nt++)
#pragma unroll
      for (int i = 0; i < 16; i++) {
        const int ml = wm * 64 + mt * 32 + crow(i, h), nl = wn * 64 + nt * 32 + (lane & 31);
        T[ml * 136 + nl] = f2bf(f(m0 + ml, n0 + nl, acc[mt][nt][i]));
      }
  __syncthreads();
#pragma unroll
  for (int j = 0; j < 8; j++) {
    const int idx = tid + 256 * j, row = idx >> 4, ch = idx & 15;
    *(uint4*)(dst0 + (long)row * ld + ch * 8) = *(const uint4*)(T + row * 136 + ch * 8);
  }
  __syncthreads();
}

template <class F>
DI void epi_bf16_vtile(const f32x16 (&acc)[2][2], u16* dst0  , char* smem, F f) {
  const int tid = opaque_tid(), lane = tid & 63, w = tid >> 6, wm = w >> 1, wn = w & 1, h = lane >> 5;
  u16* T = (u16*)smem;
#pragma unroll
  for (int mt = 0; mt < 2; mt++)
#pragma unroll
    for (int nt = 0; nt < 2; nt++)
#pragma unroll
      for (int i = 0; i < 16; i++) {
        const int ml = wm * 64 + mt * 32 + crow(i, h), nl = wn * 64 + nt * 32 + (lane & 31);
        T[ml * 136 + nl] = f2bf(f(acc[mt][nt][i]));
      }
  __syncthreads();
#pragma unroll
  for (int j = 0; j < 8; j++) {
    const int idx = tid + 256 * j, row = idx >> 4, ch = idx & 15;
    *(uint4*)(dst0 + ((long)(ch >> 3) * 128 + row) * 64 + (ch & 7) * 8) = *(const uint4*)(T + row * 136 + ch * 8);
  }
  __syncthreads();
}

template <int DQK>
DI void attn_item(const u16* Qb, long ldq, const u16* K1, long ldk1, const u16* K2, long ldk2,
                  const u16* VT, long ldvt, int nkt, int nkt_w, u16* Ob, long ldo, char* smem, bool rev = false, int vtile = 64) {
  constexpr int KLD = DQK + 8;
  constexpr int NCH = DQK / 8;
  constexpr int NKC = 64 * NCH / 256;
  constexpr int NQF = DQK / 16;
  u16* Ks = (u16*)smem;
  u16* Vs = Ks + 64 * KLD;
  int tid_ = threadIdx.x;
  asm volatile("" : "+v"(tid_));
  const int tid = tid_, lane = tid & 63, w = tid >> 6, h = lane >> 5, r = lane & 31;
  constexpr int NQR = (NQF > 8) ? 8 : NQF;
  bf16x8 qf[NQR];
  const u16* qp = Qb + (long)(w * 32 + r) * ldq + h * 8;
  if (nkt_w > 0) {
#pragma unroll
    for (int ks = 0; ks < NQR; ks++) qf[ks] = *(const bf16x8*)(qp + ks * 16);
  } else {
#pragma unroll
    for (int ks = 0; ks < NQR; ks++) qf[ks] = (bf16x8){0, 0, 0, 0, 0, 0, 0, 0};
  }
  u16* Qs = Vs + 128 * 68;
  if (NQF > NQR) {
    const int qrow = tid >> 1, qhalf = tid & 1;
    const bool qvalid = (nkt_w > 0) || (qrow < 64);
    const u16* qsrc = Qb + (long)qrow * ldq + NQR * 16 + qhalf * 32;
#pragma unroll
    for (int c = 0; c < 4; c++) {
      uint4 v = make_uint4(0, 0, 0, 0);
      if (qvalid) v = *(const uint4*)(qsrc + c * 8);
      *(uint4*)(Qs + qrow * 72 + qhalf * 32 + c * 8) = v;
    }
  }
  f32x16 o[4];
#pragma unroll
  for (int mc = 0; mc < 4; mc++)
#pragma unroll
    for (int i = 0; i < 16; i++) o[mc][i] = 0.f;
  float m_run = -1e30f, l_run = 0.f;
  uint4 rk0, rk1, rk2, rk3, rk4 = make_uint4(0, 0, 0, 0), rk5 = make_uint4(0, 0, 0, 0), rv0, rv1, rv2, rv3;
  const unsigned voffK = (unsigned)(((tid >> 4) * (int)ldk1 + (tid & 15) * 8) * 2);
  const unsigned voffR = (unsigned)(((tid >> 3) * (int)ldk2 + (tid & 7) * 8) * 2);
  const unsigned voffV = (unsigned)(((tid >> 3) * (int)ldvt + (tid & 7) * 8) * 2);
  u16* const ldsK = Ks + (tid >> 4) * KLD + (tid & 15) * 8;
  u16* const ldsR = Ks + (tid >> 3) * KLD + (16 + (tid & 7)) * 8;
  u16* const ldsV = Vs + (tid >> 3) * 68 + (tid & 7) * 8;
#define ATT_KP(i_, kt_) ((const char*)K1 + ((long)((kt_) * 64 + 16 * (i_)) * ldk1) * 2 + voffK)
#define ATT_RP(i_, kt_) ((const char*)K2 + ((long)((kt_) * 64 + 32 * (i_)) * ldk2) * 2 + voffR)
#define ATT_VP(i_, kt_) ((const char*)VT + ((long)(32 * (i_)) * ldvt + (long)(kt_) * vtile) * 2 + voffV)
#define ATT_GLOAD(kt_) do { \
    rk0 = *(const uint4*)ATT_KP(0, kt_); rk1 = *(const uint4*)ATT_KP(1, kt_); \
    rk2 = *(const uint4*)ATT_KP(2, kt_); rk3 = *(const uint4*)ATT_KP(3, kt_); \
    if (DQK == 192) { rk4 = *(const uint4*)ATT_RP(0, kt_); rk5 = *(const uint4*)ATT_RP(1, kt_); } \
    rv0 = *(const uint4*)ATT_VP(0, kt_); rv1 = *(const uint4*)ATT_VP(1, kt_); \
    rv2 = *(const uint4*)ATT_VP(2, kt_); rv3 = *(const uint4*)ATT_VP(3, kt_); } while (0)
#define ATT_VST(i_, v_) do { uint2* d_ = (uint2*)(ldsV + 32 * (i_) * 68); \
    d_[0] = make_uint2((v_).x, (v_).y); d_[1] = make_uint2((v_).z, (v_).w); } while (0)
#define ATT_SSTORE() do { \
    *(uint4*)(ldsK) = rk0; *(uint4*)(ldsK + 16 * KLD) = rk1; *(uint4*)(ldsK + 32 * KLD) = rk2; *(uint4*)(ldsK + 48 * KLD) = rk3; \
    if (DQK == 192) { *(uint4*)(ldsR) = rk4; *(uint4*)(ldsR + 32 * KLD) = rk5; } \
    ATT_VST(0, rv0); ATT_VST(1, rv1); ATT_VST(2, rv2); ATT_VST(3, rv3); } while (0)
  ATT_GLOAD(rev ? nkt - 1 : 0);
  for (int kt = 0; kt < nkt; kt++) {
    __syncthreads();
    ATT_SSTORE();
    __syncthreads();
    const int ktile = rev ? nkt - 1 - kt : kt;
    const bool active = ktile < nkt_w;
    f32x16 s[2];
    if (active) {
      const f32x16 zero16 = {0.f, 0.f, 0.f, 0.f, 0.f, 0.f, 0.f, 0.f, 0.f, 0.f, 0.f, 0.f, 0.f, 0.f, 0.f, 0.f};
      bf16x8 qx[(NQF > NQR) ? (NQF - NQR) : 1];
      if (NQF > NQR) {
#pragma unroll
        for (int ks = NQR; ks < NQF; ks++) qx[ks - NQR] = *(const bf16x8*)(Qs + (w * 32 + r) * 72 + (ks - NQR) * 16 + h * 8);
      }
      __builtin_amdgcn_s_setprio(1);
#pragma unroll
      for (int ks = 0; ks < NQF; ks++) {
#pragma unroll
        for (int mt = 0; mt < 2; mt++) {
          const bf16x8 kf = *(const bf16x8*)(Ks + (mt * 32 + r) * KLD + ks * 16 + h * 8);
          s[mt] = MFMA(kf, (ks < NQR) ? qf[ks < NQR ? ks : 0] : qx[ks >= NQR ? ks - NQR : 0], (ks == 0) ? zero16 : s[mt]);
        }
        if ((ks & 3) == 3) __builtin_amdgcn_sched_barrier(0);
      }
      __builtin_amdgcn_s_setprio(0);
    }
    __builtin_amdgcn_sched_barrier(0);
    if (kt + 1 < nkt) ATT_GLOAD(rev ? ktile - 1 : ktile + 1);
    __builtin_amdgcn_sched_barrier(0);
    if (active) {
      float mx = s[0][0];
#pragma unroll
      for (int mt = 0; mt < 2; mt++)
#pragma unroll
        for (int i = 0; i < 16; i++) mx = fmaxf(mx, s[mt][i]);
      mx = fmaxf(mx, __shfl_xor(mx, 32));
      if (__builtin_amdgcn_ballot_w64(mx > m_run + 8.f) != 0ull) {
        const float m_new = fmaxf(m_run, mx);
        const float alpha = __builtin_amdgcn_exp2f(m_run - m_new);
        m_run = m_new;
        l_run *= alpha;
#pragma unroll
        for (int mc = 0; mc < 4; mc++)
#pragma unroll
          for (int i = 0; i < 16; i++) o[mc][i] *= alpha;
      }
      float sum = 0.f;
#pragma unroll
      for (int mt = 0; mt < 2; mt++)
#pragma unroll
        for (int i = 0; i < 16; i++) { const float e = __builtin_amdgcn_exp2f(s[mt][i] - m_run); s[mt][i] = e; sum += e; }
      l_run += sum;
      __builtin_amdgcn_s_setprio(1);
#pragma unroll
      for (int mt = 0; mt < 2; mt++) {
#pragma unroll
        for (int sp = 0; sp < 2; sp++) {
          const int st = 2 * mt + sp;
          unsigned pp[4];
#pragma unroll
          for (int j = 0; j < 4; j++) pp[j] = pack2(s[mt][8 * sp + 2 * j], s[mt][8 * sp + 2 * j + 1]);
          const bf16x8 pf = __builtin_bit_cast(bf16x8, make_uint4(pp[0], pp[1], pp[2], pp[3]));
#pragma unroll
          for (int mc = 0; mc < 4; mc++) {
            const u16* vp = Vs + (mc * 32 + r) * 68 + 16 * st + 4 * h;
            const uint2 lo = *(const uint2*)vp;
            const uint2 hi = *(const uint2*)(vp + 8);
            const bf16x8 vf = __builtin_bit_cast(bf16x8, make_uint4(lo.x, lo.y, hi.x, hi.y));
            o[mc] = MFMA(vf, pf, o[mc]);
          }
          __builtin_amdgcn_sched_barrier(0);
        }
      }
      __builtin_amdgcn_s_setprio(0);
    }
  }
  if (nkt_w > 0) {
    const float l = l_run + __shfl_xor(l_run, 32);
    const float inv = __builtin_amdgcn_rcpf(l);
    u16* op = Ob + (long)(w * 32 + r) * ldo;
#pragma unroll
    for (int mc = 0; mc < 4; mc++)
#pragma unroll
      for (int g = 0; g < 4; g++) {
        uint2 v;
        v.x = pack2(o[mc][4 * g] * inv, o[mc][4 * g + 1] * inv);
        v.y = pack2(o[mc][4 * g + 2] * inv, o[mc][4 * g + 3] * inv);
        *(uint2*)(op + mc * 32 + 8 * g + 4 * h) = v;
      }
  }
}

DI const float* xrow(const Params& p, int t) { return t < NP ? p.in[I_XP] + (long)t * 1024 : p.in[I_XS] + (long)(t - NP) * 1024; }
DI int tok_pos(int t) { return t < NP ? t : 1024 + ((t - NP) & 63); }
DI int tok_kv(int t) { return t < NP ? t : NP + ((t - NP) >> 6) * 1088 + 1024 + ((t - NP) & 63); }

constexpr int XR_LD = 2048;
DI u16* xres_base(const Params& p) { return (u16*)(p.out + O_Y) + 1024; }
DI void rowwise_residual(const Params& p, const u16* Y, const float* gpost, int mode, const u16* parts) {
  const int tid = opaque_tid(), lane = tid & 63, w = tid >> 6;
  float* y = p.out + O_Y;
  u16* xr = xres_base(p);
  float* rs = (float*)(p.ws + W_RS);
  const int stride = gridDim.x * 4;
  for (int tb = blockIdx.x * 4 + w; tb < NT; tb += 2 * stride) {
    float4 yv[2][4], xv[2][4];
    float ss[2] = {0.f, 0.f};
#pragma unroll
    for (int u = 0; u < 2; u++) {
      const int t = tb + u * stride;
      if (t < NT) {
#pragma unroll
        for (int j = 0; j < 4; j++) {
          const uint2 yr = *(const uint2*)(Y + (long)t * 1024 + j * 256 + lane * 4);
          yv[u][j] = make_float4(bf2f((u16)(yr.x & 0xffff)), bf2f((u16)(yr.x >> 16)), bf2f((u16)(yr.y & 0xffff)), bf2f((u16)(yr.y >> 16)));
          if (mode == 0) xv[u][j] = *(const float4*)(xrow(p, t) + j * 256 + lane * 4);
          else {
            const uint2 xq_ = *(const uint2*)(xr + (long)t * XR_LD + j * 256 + lane * 4);
            xv[u][j] = make_float4(bf2f((u16)(xq_.x & 0xffff)), bf2f((u16)(xq_.x >> 16)), bf2f((u16)(xq_.y & 0xffff)), bf2f((u16)(xq_.y >> 16)));
          }
        }
        if (lane >= 32 && t >= 2048) {
#pragma unroll
          for (int q = 0; q < 3; q++) {
            const uint2 pv = *(const uint2*)(parts + ((long)q * NT + t) * 128 + (lane - 32) * 4);
            yv[u][3].x += bf2f((u16)(pv.x & 0xffff)); yv[u][3].y += bf2f((u16)(pv.x >> 16));
            yv[u][3].z += bf2f((u16)(pv.y & 0xffff)); yv[u][3].w += bf2f((u16)(pv.y >> 16));
          }
        }
#pragma unroll
        for (int j = 0; j < 4; j++) ss[u] += yv[u][j].x * yv[u][j].x + yv[u][j].y * yv[u][j].y + yv[u][j].z * yv[u][j].z + yv[u][j].w * yv[u][j].w;
      }
    }
    ss[0] = wave_sum(ss[0]); ss[1] = wave_sum(ss[1]);
#pragma unroll
    for (int u = 0; u < 2; u++) {
      const int t = tb + u * stride;
      if (t < NT) {
        const float r = rsqrtf(ss[u] * (1.f / 1024.f) + EPS);
        float s2 = 0.f;
#pragma unroll
        for (int j = 0; j < 4; j++) {
          const float4 g = *(const float4*)(gpost + j * 256 + lane * 4);
          float4 xn = xv[u][j];
          xn.x += yv[u][j].x * r * g.x; xn.y += yv[u][j].y * r * g.y; xn.z += yv[u][j].z * r * g.z; xn.w += yv[u][j].w * r * g.w;
          s2 += xn.x * xn.x + xn.y * xn.y + xn.z * xn.z + xn.w * xn.w;
          if (mode == 2) *(float4*)(y + (long)t * 1024 + j * 256 + lane * 4) = xn;
          else {
            uint2 o; o.x = pack2(xn.x, xn.y); o.y = pack2(xn.z, xn.w);
            *(uint2*)(xr + (long)t * XR_LD + j * 256 + lane * 4) = o;
          }
        }
        if (mode != 2) {
          s2 = wave_sum(s2);
          if (lane == 0) rs[t] = rsqrtf(s2 * (1.f / 1024.f) + EPS);
        }
      }
    }
  }
}

constexpr int NSKV = 32 * 1088;
DI void attn_phase_l0(const Params& p, int g, unsigned* qcnt, char* smem) {
  char* ws = launder(p.ws);
  u16* Q = (u16*)(ws + W_Q);
  const u16* knp = (const u16*)(ws + W_KNP);
  const u16* vtp = (const u16*)(ws + W_VTP);
  const u16* kns = (const u16*)(ws + W_KNS);
  const u16* vts = (const u16*)(ws + W_VTS);
  const u16* krall = (const u16*)(ws + W_KRALL);
  u16* xq = (u16*)(ws + W_XQ0);
  const u16* memk_p = (const u16*)(ws + W_MEMKP);
  const u16* memvT_p = (const u16*)(ws + W_MEMVTP);
  const u16* memk_s = (const u16*)(ws + W_MEMKS0);
  const u16* memvT_s = (const u16*)(ws + W_MEMVTS0);
  volatile int* qslot = (volatile int*)(smem + SMEM_MAIN + 16);
  const int n_mla_p = (g == 0) ? 1024 : 0, n_mla_s = 128, n_cross = (g == 0) ? 512 + 128 : 0;
  const int total = n_mla_p + n_mla_s + n_cross;
  int hoff = (g == 0) ? 0 : 8;
  const int h0 = (int)(xb_xcc_id() & 7u);
  for (;;) {
    __syncthreads();
    if (threadIdx.x == 0) {
      int item = -1;
      while (hoff < 8) {
        const int hd_ = (h0 + hoff) & 7;
        const unsigned k_ = atomicAdd(qcnt + 8 + hd_, 1u);
        if (k_ < 128u) { item = (int)k_ * 8 + hd_; break; }
        hoff++;
      }
      if (item < 0) item = n_mla_p + (int)atomicAdd(qcnt, 1u);
      *qslot = item;
    }
    __syncthreads();
    const int it = *qslot;
    if (it >= total) break;
    const int w = threadIdx.x >> 6;
    if (it < n_mla_p) {
      const int qt = 127 - (it >> 3), hd = it & 7;
      const int nkt = 2 * qt + 2, nkw = (w < 2) ? 2 * qt + 1 : 2 * qt + 2;
      u16* qb = Q + (long)qt * 128 * 1536 + hd * 192;
      attn_item<192>(qb, 1536, knp + (long)hd * NP * 128, 128, krall, 64, vtp + (long)hd * (NP / 64) * 8192, 64, nkt, nkw, qb, 1536, smem, qt < 64, 8192);
    } else if (it < n_mla_p + n_mla_s) {
      const int j = it - n_mla_p, b = j >> 2, hl = j & 3, hd = 4 * g + hl;
      const long s0 = (long)b * 1088;
      u16* qb = Q + (long)(NP + b * 64) * 1536 + hd * 192;
      attn_item<192>(qb, 1536, kns + ((long)hl * NSKV + s0) * 128, 128, krall + ((long)NP + s0) * 64, 64, vts + ((long)hl * (NSKV / 64) + b * 17) * 8192, 64,
                     17, (w < 2) ? 17 : 0, qb, 1536, smem, false, 8192);
    } else {
      const int j = it - n_mla_p - n_mla_s;
      if (j < 512) {
        const int qt = j >> 2, hx = j & 3;
        u16* qb = xq + (long)qt * 128 * 512 + hx * 128;
        attn_item<128>(qb, 512, memk_p + hx * 128, 512, nullptr, 0, memvT_p + (long)hx * 128 * 256, 256, 4, 4, qb, 512, smem);
      } else {
        const int jj = j - 512, b = jj >> 2, hx = jj & 3;
        u16* qb = xq + (long)(NP + b * 64) * 512 + hx * 128;
        attn_item<128>(qb, 512, memk_s + (long)b * 256 * 512 + hx * 128, 512, nullptr, 0,
                       memvT_s + (long)(b * 4 + hx) * 128 * 256, 256, 4, (w < 2) ? 4 : 0, qb, 512, smem);
      }
    }
  }
}
DI void cross_phase_l1(const Params& p, unsigned* qcnt, char* smem) {
  char* ws = launder(p.ws);
  u16* xq = (u16*)(ws + W_XQ1);
  const u16* memk_p = (const u16*)(ws + W_MEMKP) + 256 * 512;
  const u16* memvT_p = (const u16*)(ws + W_MEMVTP) + 4 * 128 * 256;
  const u16* memk_s = (const u16*)(ws + W_MEMKS1);
  const u16* memvT_s = (const u16*)(ws + W_MEMVTS1);
  volatile int* qslot = (volatile int*)(smem + SMEM_MAIN + 16);
  for (;;) {
    __syncthreads();
    if (threadIdx.x == 0) *qslot = (int)atomicAdd(qcnt, 1u);
    __syncthreads();
    const int j = *qslot;
    if (j >= 640) break;
    const int w = threadIdx.x >> 6;
    if (j < 512) {
      const int qt = j >> 2, hx = j & 3;
      u16* qb = xq + (long)qt * 128 * 512 + hx * 128;
      attn_item<128>(qb, 512, memk_p + hx * 128, 512, nullptr, 0, memvT_p + (long)hx * 128 * 256, 256, 4, 4, qb, 512, smem);
    } else {
      const int jj = j - 512, b = jj >> 2, hx = jj & 3;
      u16* qb = xq + (long)(NP + b * 64) * 512 + hx * 128;
      attn_item<128>(qb, 512, memk_s + (long)b * 256 * 512 + hx * 128, 512, nullptr, 0,
                     memvT_s + (long)(b * 4 + hx) * 128 * 256, 256, 4, (w < 2) ? 4 : 0, qb, 512, smem);
    }
  }
}

DI void hgrn_chunk_item(const Params& p, int n, int hd, char* smem) {
  char* ws = launder(p.ws);
  u16* qs = (u16*)(ws + W_QS);
  float* f = (float*)(ws + W_F);
  const u16* vv = (const u16*)(ws + W_V);
  u16* U = (u16*)(ws + W_U);
  float* decay = (float*)(ws + W_DECAY);
  const float* lbv = (const float*)(ws + W_LBV);
  u16* QS = (u16*)smem;
  u16* KS = QS + 64 * 136;
  u16* KDT = KS + 64 * 136;
  u16* VTs = KDT + 128 * 68;
  float* tot = (float*)(VTs + 128 * 68);
  float* lg32 = tot + 256;
  const int tid = opaque_tid(), lane = tid & 63, w = tid >> 6, h = lane >> 5, r = lane & 31;
  const int d = tid & 127, hf = tid >> 7;
  const long t0 = (n < 256) ? (long)n * 64 : (long)NP + (long)(n - 256) * 64;
  const int col = hd * 128 + d;
  const float lb = lbv[col];
  __syncthreads();
  {
    float run = 0.f;
#pragma unroll 1
    for (int j0 = 0; j0 < 32; j0 += 16) {
      float fv[16];
#pragma unroll
      for (int jj = 0; jj < 16; jj++) fv[jj] = f[(t0 + hf * 32 + j0 + jj) * 1024 + col];
#pragma unroll
      for (int jj = 0; jj < 16; jj++) {
        const float lg = __logf(lb + (1.f - lb) * sigmoidf_(fv[jj]));
        if (j0 + jj == 0 && hf == 1) lg32[d] = lg;
        run += lg;
      }
    }
    tot[hf * 128 + d] = run;
  }
  __syncthreads();
  {
    const float tot0 = tot[d], blast = tot0 + tot[128 + d], ref = tot0 + lg32[d];
    float b = hf ? tot0 : 0.f;
    if (hf == 0) decay[((long)n * 8 + hd) * 128 + d] = __expf(blast);
#pragma unroll 1
    for (int j0 = 0; j0 < 32; j0 += 8) {
      float fv[8]; u16 qv[8], vv8[8];
#pragma unroll
      for (int jj = 0; jj < 8; jj++) {
        const long gi = (t0 + hf * 32 + j0 + jj) * 1024 + col;
        fv[jj] = f[gi]; qv[jj] = qs[gi]; vv8[jj] = vv[gi];
      }
#pragma unroll
      for (int jj = 0; jj < 8; jj++) {
        const int t = hf * 32 + j0 + jj;
        const long gi = (t0 + t) * 1024 + col;
        const float sg = sigmoidf_(fv[jj]);
        b += __logf(lb + (1.f - lb) * sg);
        const float kk = (1.f - lb) * sigmoidf_(-fv[jj]);
        const float q = bf2f(qv[jj]);
        QS[t * 136 + d] = f2bf(q * __expf(b - ref));
        KS[t * 136 + d] = f2bf(kk * __expf(ref - b));
        KDT[d * 68 + t] = f2bf(kk * __expf(blast - b));
        VTs[d * 68 + t] = vv8[jj];
        qs[gi] = f2bf(q * __expf(b));
      }
    }
  }
  __syncthreads();
  {
    const int ntl = w & 1, vh = w >> 1;
    f32x16 at[2];
#pragma unroll
    for (int ms = 0; ms < 2; ms++)
#pragma unroll
      for (int i = 0; i < 16; i++) at[ms][i] = 0.f;
#pragma unroll
    for (int ms = 0; ms < 2; ms++) {
      if (ms <= ntl) {
#pragma unroll
        for (int ks = 0; ks < 8; ks++) {
          const bf16x8 a = *(const bf16x8*)(KS + (ms * 32 + r) * 136 + ks * 16 + h * 8);
          const bf16x8 b = *(const bf16x8*)(QS + (ntl * 32 + r) * 136 + ks * 16 + h * 8);
          at[ms] = MFMA(a, b, at[ms]);
        }
        if (ms == ntl) {
#pragma unroll
          for (int i = 0; i < 16; i++) if (crow(i, h) > r) at[ms][i] = 0.f;
        }
      }
    }
    f32x16 o[2];
#pragma unroll
    for (int mv = 0; mv < 2; mv++)
#pragma unroll
      for (int i = 0; i < 16; i++) o[mv][i] = 0.f;
#pragma unroll
    for (int ms = 0; ms < 2; ms++)
#pragma unroll
      for (int sp = 0; sp < 2; sp++) {
        const int st = 2 * ms + sp;
        unsigned pp[4];
#pragma unroll
        for (int j = 0; j < 4; j++) pp[j] = pack2(at[ms][8 * sp + 2 * j], at[ms][8 * sp + 2 * j + 1]);
        const bf16x8 pf = __builtin_bit_cast(bf16x8, make_uint4(pp[0], pp[1], pp[2], pp[3]));
#pragma unroll
        for (int mv = 0; mv < 2; mv++) {
          const u16* vp = VTs + ((vh * 2 + mv) * 32 + r) * 68 + 16 * st + 4 * h;
          const uint2 lo = *(const uint2*)vp;
          const uint2 hi = *(const uint2*)(vp + 8);
          const bf16x8 vf = __builtin_bit_cast(bf16x8, make_uint4(lo.x, lo.y, hi.x, hi.y));
          o[mv] = MFMA(vf, pf, o[mv]);
        }
      }
    float* op = f + (t0 + ntl * 32 + r) * 1024 + hd * 128;
#pragma unroll
    for (int mv = 0; mv < 2; mv++)
#pragma unroll
      for (int g = 0; g < 4; g++)
        *(float4*)(op + (vh * 2 + mv) * 32 + 8 * g + 4 * h) = make_float4(o[mv][4 * g], o[mv][4 * g + 1], o[mv][4 * g + 2], o[mv][4 * g + 3]);
  }
  {
    f32x16 u[4];
#pragma unroll
    for (int nk = 0; nk < 4; nk++)
#pragma unroll
      for (int i = 0; i < 16; i++) u[nk][i] = 0.f;
#pragma unroll
    for (int ss = 0; ss < 4; ss++) {
      const u16* ap = VTs + (w * 32 + r) * 68 + ss * 16 + h * 8;
      const uint2 alo = *(const uint2*)ap, ahi = *(const uint2*)(ap + 4);
      const bf16x8 a = __builtin_bit_cast(bf16x8, make_uint4(alo.x, alo.y, ahi.x, ahi.y));
#pragma unroll
      for (int nk = 0; nk < 4; nk++) {
        const u16* bp = KDT + (nk * 32 + r) * 68 + ss * 16 + h * 8;
        const uint2 blo = *(const uint2*)bp, bhi = *(const uint2*)(bp + 4);
        const bf16x8 b = __builtin_bit_cast(bf16x8, make_uint4(blo.x, blo.y, bhi.x, bhi.y));
        u[nk] = MFMA(a, b, u[nk]);
      }
    }
    u16* up = U + ((long)n * 8 + hd) * 128 * 128;
#pragma unroll
    for (int nk = 0; nk < 4; nk++)
#pragma unroll
      for (int i = 0; i < 16; i++) up[(w * 32 + crow(i, h)) * 128 + nk * 32 + r] = f2bf(u[nk][i]);
  }
}

DI void hgrn_scan_phase(const Params& p, char* smem) {
  char* ws = launder(p.ws);
  u16* U = (u16*)(ws + W_U);
  const float* decay = (const float*)(ws + W_DECAY);
  const int tid = opaque_tid();
  for (int it = blockIdx.x; it < 512; it += gridDim.x) {
    const int hd = it >> 6, v = (it & 63) * 2 + (tid >> 7), k = tid & 127;
    u16* up = U + ((long)hd * 128 + v) * 128 + k;
    const float* dp = decay + hd * 128 + k;
    float S = 0.f;
    float cu[8], cd[8];
#pragma unroll
    for (int j = 0; j < 8; j++) { cu[j] = bf2f(up[(long)j * 131072]); cd[j] = dp[j * 1024]; }
    for (int n0 = 0; n0 < 256; n0 += 8) {
      float nu[8], nd[8];
      if (n0 + 8 < 256) {
#pragma unroll
        for (int j = 0; j < 8; j++) { nu[j] = bf2f(up[(long)(n0 + 8 + j) * 131072]); nd[j] = dp[(n0 + 8 + j) * 1024]; }
      } else {
#pragma unroll
        for (int j = 0; j < 8; j++) { nu[j] = 0.f; nd[j] = 0.f; }
      }
#pragma unroll
      for (int j = 0; j < 8; j++) { up[(long)(n0 + j) * 131072] = f2bf(S); S = cd[j] * S + cu[j]; }
#pragma unroll
      for (int j = 0; j < 8; j++) { cu[j] = nu[j]; cd[j] = nd[j]; }
    }
    p.out[O_HGP + ((long)hd * 128 + k) * 128 + v] = S;
  }
  float* t1 = (float*)smem;
  float* t2 = t1 + 32 * 33;
  for (int it = blockIdx.x; it < 4096; it += gridDim.x) {
    const int bh = it >> 4, kt = (it >> 2) & 3, vt = it & 3, b = bh >> 3, hd = bh & 7;
    const float* s0 = p.in[I_CHS] + (long)bh * 16384;
    float* so = p.out + O_HGS + (long)bh * 16384;
    const int n = 256 + b;
    u16* up = U + ((long)n * 8 + hd) * 16384;
    const float* dp = decay + ((long)n * 8 + hd) * 128;
    const int c = tid & 31, r0 = tid >> 5;
    __syncthreads();
#pragma unroll
    for (int j = 0; j < 4; j++) { const int rr = r0 + 8 * j; t1[rr * 33 + c] = s0[(kt * 32 + rr) * 128 + vt * 32 + c]; }
    __syncthreads();
#pragma unroll
    for (int j = 0; j < 4; j++) {
      const int vl = r0 + 8 * j, kl = c;
      const float sv = t1[kl * 33 + vl];
      const long ui = (long)(vt * 32 + vl) * 128 + kt * 32 + kl;
      const float uv = bf2f(up[ui]);
      up[ui] = f2bf(sv);
      t2[kl * 33 + vl] = dp[kt * 32 + kl] * sv + uv;
    }
    __syncthreads();
#pragma unroll
    for (int j = 0; j < 4; j++) { const int rr = r0 + 8 * j; so[(kt * 32 + rr) * 128 + vt * 32 + c] = t2[rr * 33 + c]; }
  }
}

DI void hgrn_final_item(const Params& p, int n, int hd, char* smem) {
  char* ws = launder(p.ws);
  u16* qb = (u16*)(ws + W_QS);
  const float* oi = (const float*)(ws + W_F);
  const u16* gs = (const u16*)(ws + W_GS);
  const u16* U = (const u16*)(ws + W_U);
  const float* gon = p.in[I_ONORM];
  u16* Ss = (u16*)smem;
  u16* Qb = Ss + 128 * 136;
  float* T = (float*)smem;
  const int tid = opaque_tid(), lane = tid & 63, w = tid >> 6, h = lane >> 5, r = lane & 31;
  const int ntl = w & 1, vh = w >> 1;
  const long t0 = (n < 256) ? (long)n * 64 : (long)NP + (long)(n - 256) * 64;
  const u16* sp = U + ((long)n * 8 + hd) * 16384;
  __syncthreads();
  {
    uint4 sv[8], qv[4];
    const int row = tid >> 4, ch = tid & 15;
#pragma unroll
    for (int j = 0; j < 8; j++) sv[j] = *(const uint4*)(sp + (row + 16 * j) * 128 + ch * 8);
#pragma unroll
    for (int j = 0; j < 4; j++) qv[j] = *(const uint4*)(qb + (t0 + row + 16 * j) * 1024 + hd * 128 + ch * 8);
#pragma unroll
    for (int j = 0; j < 8; j++) *(uint4*)(Ss + (row + 16 * j) * 136 + ch * 8) = sv[j];
#pragma unroll
    for (int j = 0; j < 4; j++) *(uint4*)(Qb + (row + 16 * j) * 136 + ch * 8) = qv[j];
  }
  __syncthreads();
  f32x16 o[2];
#pragma unroll
  for (int mv = 0; mv < 2; mv++)
#pragma unroll
    for (int i = 0; i < 16; i++) o[mv][i] = 0.f;
#pragma unroll
  for (int ks = 0; ks < 8; ks++) {
    const bf16x8 b = *(const bf16x8*)(Qb + (ntl * 32 + r) * 136 + ks * 16 + h * 8);
#pragma unroll
    for (int mv = 0; mv < 2; mv++) {
      const bf16x8 a = *(const bf16x8*)(Ss + ((vh * 2 + mv) * 32 + r) * 136 + ks * 16 + h * 8);
      o[mv] = MFMA(a, b, o[mv]);
    }
  }
  __syncthreads();
#pragma unroll
  for (int mv = 0; mv < 2; mv++)
#pragma unroll
    for (int g = 0; g < 4; g++)
      *(float4*)(T + (ntl * 32 + r) * 132 + (vh * 2 + mv) * 32 + 8 * g + 4 * h) = make_float4(o[mv][4 * g], o[mv][4 * g + 1], o[mv][4 * g + 2], o[mv][4 * g + 3]);
  __syncthreads();
  {
    const int t = tid >> 2, c0 = (tid & 3) * 32;
    const long grow = (t0 + t) * 1024 + hd * 128 + c0;
    float x[32];
    float ss = 0.f;
#pragma unroll
    for (int j = 0; j < 8; j++) {
      const float4 tv = *(const float4*)(T + t * 132 + c0 + 4 * j);
      const float4 ov = *(const float4*)(oi + grow + 4 * j);
      x[4 * j] = tv.x + ov.x; x[4 * j + 1] = tv.y + ov.y; x[4 * j + 2] = tv.z + ov.z; x[4 * j + 3] = tv.w + ov.w;
      ss += x[4 * j] * x[4 * j] + x[4 * j + 1] * x[4 * j + 1] + x[4 * j + 2] * x[4 * j + 2] + x[4 * j + 3] * x[4 * j + 3];
    }
    ss += __shfl_xor(ss, 1);
    ss += __shfl_xor(ss, 2);
    const float rsn = rsqrtf(ss * (1.f / 128.f) + EPS);
#pragma unroll
    for (int j = 0; j < 4; j++) {
      const uint4 gg = *(const uint4*)(gs + grow + 8 * j);
      const float4 ga = *(const float4*)(gon + c0 + 8 * j), gb = *(const float4*)(gon + c0 + 8 * j + 4);
      uint4 ov;
      ov.x = pack2(x[8 * j] * rsn * ga.x * bf2f((u16)(gg.x & 0xffff)), x[8 * j + 1] * rsn * ga.y * bf2f((u16)(gg.x >> 16)));
      ov.y = pack2(x[8 * j + 2] * rsn * ga.z * bf2f((u16)(gg.y & 0xffff)), x[8 * j + 3] * rsn * ga.w * bf2f((u16)(gg.y >> 16)));
      ov.z = pack2(x[8 * j + 4] * rsn * gb.x * bf2f((u16)(gg.z & 0xffff)), x[8 * j + 5] * rsn * gb.y * bf2f((u16)(gg.z >> 16)));
      ov.w = pack2(x[8 * j + 6] * rsn * gb.z * bf2f((u16)(gg.w & 0xffff)), x[8 * j + 7] * rsn * gb.w * bf2f((u16)(gg.w >> 16)));
      *(uint4*)(qb + grow + 8 * j) = ov;
    }
  }
}

template <class AL, class BL, class EP>
DI void gemm_phase(int MT, int NTL, int K, AL al, BL bl, EP ep, char* smem) {
  for (int t = blockIdx.x; t < MT * NTL; t += gridDim.x) {
    const int tm = t % MT, tn = t / MT;
    f32x16 acc[2][2];
    gemm_core(al, bl, tm * 128, tn * 128, K, smem, acc);
    ep(acc, tm * 128, tn * 128);
  }
}

template <class AL, class BL>
DI void gemm_phase_n1024(int K, AL al, BL bl, u16* Y, u16* parts, char* smem) {
  for (int u = blockIdx.x; u < 1024 + 512; u += gridDim.x) {
    f32x16 acc[2][2];
    if (u < 1024) {
      const int tm = u % 144, tn = u / 144;
      gemm_core(al, bl, tm * 128, tn * 128, K, smem, acc);
      epi_bf16_tile(acc, tm * 128, tn * 128, Y + (long)tm * 128 * 1024 + tn * 128, 1024, smem, [=](int m, int n, float v) { return v; });
    } else {
      const int v = u - 1024, t = 1024 + (v >> 2), q = v & 3, tm = t % 144, tn = t / 144;
      const int koff = q * (K / 4);
      gemm_core([=](int m, int k) { return al(m, k + koff); }, [=](int n, int k) { return bl(n, k + koff); },
                tm * 128, tn * 128, K / 4, smem, acc);
      if (q == 0) epi_bf16_tile(acc, tm * 128, tn * 128, Y + (long)tm * 128 * 1024 + tn * 128, 1024, smem, [=](int m, int n, float vv) { return vv; });
      else epi_bf16_tile(acc, tm * 128, tn * 128, parts + (long)(q - 1) * NT * 128 + (long)tm * 128 * 128, 128, smem, [=](int m, int n, float vv) { return vv; });
    }
  }
}
DI void ffn_up_phase(const Params& p, const u16* xb, int ldx, const u16* wupT, u16* hid, char* smem) {
  const float* rs = (const float*)(p.ws + W_RS);
  gemm_phase(NT / 128, 32, 1024,
             [=](int m, int k) { return xb + (long)m * ldx + k; },
             [=](int n, int k) { return wupT + (long)n * 1024 + k; },
             [=](const f32x16 (&acc)[2][2], int m0, int n0) {
               epi_bf16_tile(acc, m0, n0, hid + (long)m0 * 4096 + n0, 4096, smem, [=](int m, int n, float v) {
                 const float a = fmaxf(v * rs[m], 0.f);
                 return a * a;
               });
             }, smem);
}
DI void ffn_down_phase(const u16* hid, const u16* wdownT, u16* Y, u16* parts, char* smem) {
  gemm_phase_n1024(4096,
                   [=](int m, int k) { return hid + (long)m * 4096 + k; },
                   [=](int n, int k) { return wdownT + (long)n * 4096 + k; }, Y, parts, smem);
}

__global__ void __launch_bounds__(256, 2) fwd_megakernel(Params p) {
  __shared__ __attribute__((aligned(16))) char smem[SMEM_TOTAL];
  unsigned* bar = (unsigned*)launder(p.ws);
  unsigned* qcnt = (unsigned*)(launder(p.ws) + W_QCNT);
  if (threadIdx.x < 4) ((volatile unsigned*)(smem + SMEM_MAIN))[threadIdx.x] = 0u;
  __syncthreads();
  (void)xcd_barrier_post(bar, (volatile LAS unsigned*)(smem + SMEM_MAIN));
#define GRID_BARRIER() do { XcdBarrier b_; b_.bar = (unsigned*)p.ws; b_.x = xb_xcc_id(); b_.st = (volatile LAS unsigned*)(smem + SMEM_MAIN); xcd_barrier(b_); } while (0)

  convert_weight(p.in[I_WIN0], 1024, 1216, 1280, p.in[I_LMPRE], (u16*)(launder(p.ws) + W_IN0T), smem);
  convert_weight(p.in[I_WUQ], 384, 1536, 1536, p.in[I_QNORM], (u16*)(launder(p.ws) + W_UQT), smem, 320);
  convert_weight(p.in[I_WUK], 256, 1024, 1024, nullptr, (u16*)(launder(p.ws) + W_UKT), smem, 464);
  convert_weight(p.in[I_WUV], 256, 1024, 1024, nullptr, (u16*)(launder(p.ws) + W_UVT), smem, 16);
  convert_weight(p.in[I_WOUT0], 1536, 1024, 1024, nullptr, (u16*)(launder(p.ws) + W_OUT0T), smem, 80);
  convert_weight(p.in[I_WMEMKV], 1024, 1024, 1024, p.in[I_MEMNORM], (u16*)(launder(p.ws) + W_MEMT), smem, 464);
  convert_weight(p.in[I_WMEMKV] + 1024 * 1024, 1024, 1024, 1024, p.in[I_MEMNORM] + 1024, (u16*)(launder(p.ws) + W_MEMT) + 1024 * 1024, smem, 208);
  convert_mem_cache(p, 0, (u16*)(launder(p.ws) + W_MEMKS0), (u16*)(launder(p.ws) + W_MEMVTS0), smem);
  {
    const int tid = opaque_tid(), lane = tid & 63, wv = tid >> 6;
    float* ct = (float*)(launder(p.ws) + W_ROPE);
    float* st = ct + 16384 * 32;
    for (long i = (long)blockIdx.x * 256 + tid; i < 16384L * 32; i += (long)gridDim.x * 256) {
      const int pos = (int)(i >> 5), j = (int)(i & 31);
      const double ang = (double)pos * p.inv_freq[j];
      const double k = rint(ang * 0.15915494309189535);
      const float rr = (float)(ang - k * 6.283185307179586);
      ct[i] = cosf(rr); st[i] = sinf(rr);
    }
    float* rs = (float*)(launder(p.ws) + W_RS);
    float* rsmem = (float*)(launder(p.ws) + W_RSMEM);
    float* y = p.out + O_Y;
    u16* xb0 = (u16*)(launder(p.ws) + W_XB0);
    for (int t = blockIdx.x * 4 + wv; t < NT; t += gridDim.x * 4) {
      const float* xr = xrow(p, t);
      float ss = 0.f;
#pragma unroll
      for (int j = 0; j < 4; j++) {
        const float4 v = ld_nt4(xr + j * 256 + lane * 4);
        ss += v.x * v.x + v.y * v.y + v.z * v.z + v.w * v.w;
        uint2 o; o.x = pack2(v.x, v.y); o.y = pack2(v.z, v.w);
        *(uint2*)(xb0 + (long)t * 1024 + j * 256 + lane * 4) = o;
      }
      ss = wave_sum(ss);
      if (lane == 0) rs[t] = rsqrtf(ss * (1.f / 1024.f) + EPS);
    }
    u16* memb = (u16*)(launder(p.ws) + W_MEMB);
    for (int t = blockIdx.x * 4 + wv; t < 256; t += gridDim.x * 4) {
      const float* xr = p.in[I_MEMP] + (long)t * 1024;
      float ss = 0.f;
#pragma unroll
      for (int j = 0; j < 4; j++) {
        const float4 v = ld_nt4(xr + j * 256 + lane * 4);
        ss += v.x * v.x + v.y * v.y + v.z * v.z + v.w * v.w;
        uint2 o; o.x = pack2(v.x, v.y); o.y = pack2(v.z, v.w);
        *(uint2*)(memb + (long)t * 1024 + j * 256 + lane * 4) = o;
      }
      ss = wave_sum(ss);
      if (lane == 0) rsmem[t] = rsqrtf(ss * (1.f / 1024.f) + EPS);
    }
    u16* latall = (u16*)(launder(p.ws) + W_LATALL);
    u16* krall = (u16*)(launder(p.ws) + W_KRALL);
    for (long i = (long)blockIdx.x * 256 + tid; i < 32L * 1024 * 64; i += (long)gridDim.x * 256) {
      const long row = i >> 6; const int c4 = (int)(i & 63);
      const int b = (int)(row >> 10), j = (int)(row & 1023);
      const float4 v = ld_nt4(p.in[I_CLAT] + row * 256 + c4 * 4);
      uint2 o; o.x = pack2(v.x, v.y); o.y = pack2(v.z, v.w);
      *(uint2*)(latall + ((long)NP + b * 1088 + j) * 256 + c4 * 4) = o;
    }
    for (long i = (long)blockIdx.x * 256 + tid; i < 32L * 1024 * 16; i += (long)gridDim.x * 256) {
      const long row = i >> 4; const int c4 = (int)(i & 15);
      const int b = (int)(row >> 10), j = (int)(row & 1023);
      const float4 v = ld_nt4(p.in[I_CKR] + row * 64 + c4 * 4);
      uint2 o; o.x = pack2(v.x, v.y); o.y = pack2(v.z, v.w);
      *(uint2*)(krall + ((long)NP + b * 1088 + j) * 64 + c4 * 4) = o;
    }
    float* lbv = (float*)(launder(p.ws) + W_LBV);
    for (int i = blockIdx.x * 256 + tid; i < 1024; i += gridDim.x * 256)
      lbv[i] = 1.f / (1.f + expf(p.in[I_LB][i] - p.in[I_LB][1024 + i]));
  }
  if (p.never) cg::this_grid().sync();
  GRID_BARRIER();

  {
    const u16* memb = (const u16*)(launder(p.ws) + W_MEMB);
    const u16* wmemT = (const u16*)(launder(p.ws) + W_MEMT);
    const u16* xb0 = (const u16*)(launder(p.ws) + W_XB0);
    const u16* win0T = (const u16*)(launder(p.ws) + W_IN0T);
    u16* P0b = (u16*)(launder(p.ws) + W_P0F);
    u16* memk_p = (u16*)(launder(p.ws) + W_MEMKP);
    u16* memvT_p = (u16*)(launder(p.ws) + W_MEMVTP);
    float* out = p.out;
    const float* rs = (const float*)(launder(p.ws) + W_RS);
    const float* rsmem = (const float*)(launder(p.ws) + W_RSMEM);
    const int n_mem = 2 * 2 * 8, n_proj = (NT / 128) * 10;
    for (int t = blockIdx.x; t < n_mem + n_proj; t += gridDim.x) {
      f32x16 acc[2][2];
      if (t < n_mem) {
        const int l = t >> 4, tm = (t >> 3) & 1, tn = t & 7;
        const u16* wl = wmemT + (long)l * 1024 * 1024;
        gemm_core([=](int m, int k) { return memb + (long)m * 1024 + k; },
                  [=](int n, int k) { return wl + (long)n * 1024 + k; }, tm * 128, tn * 128, 1024, smem, acc);
        epi_each(acc, tm * 128, tn * 128, [=](int m, int n, float v) {
          v *= rsmem[m];
          if (n < 512) {
            out[O_MKP + ((long)l * 256 + m) * 512 + n] = v;
            memk_p[((long)l * 256 + m) * 512 + n] = f2bf(v);
          } else {
            const int e = n - 512;
            out[O_MVP + ((long)l * 256 + m) * 512 + e] = v;
            memvT_p[((long)l * 512 + e) * 256 + m] = f2bf(v);
          }
        });
      } else {
        const int tt = t - n_mem, tm = tt % (NT / 128), tn = tt / (NT / 128);
        gemm_core([=](int m, int k) { return xb0 + (long)m * 1024 + k; },
                  [=](int n, int k) { return win0T + (long)n * 1024 + k; }, tm * 128, tn * 128, 1024, smem, acc);
        epi_bf16_tile(acc, tm * 128, tn * 128, P0b + (long)tm * 128 * 1280 + tn * 128, 1280, smem, [=](int m, int n, float v) { return v * rs[m]; });
      }
    }
  }
  GRID_BARRIER();

  {
    const u16* P0b = (const u16*)(launder(p.ws) + W_P0F);
    const float* ct = (const float*)(launder(p.ws) + W_ROPE);
    const float* st = ct + 16384 * 32;
    u16* cqn = (u16*)(launder(p.ws) + W_CQN);
    u16* xq = (u16*)(launder(p.ws) + W_XQ0);
    u16* latall = (u16*)(launder(p.ws) + W_LATALL);
    u16* krall = (u16*)(launder(p.ws) + W_KRALL);
    const float* gkv = p.in[I_KVNORM];
    const int tid = opaque_tid(), lane = tid & 63, wv = tid >> 6;
    const int stride2 = gridDim.x * 4;
    for (int tb = blockIdx.x * 4 + wv; tb < NT; tb += 2 * stride2) {
      u16 raw[2][19];
#pragma unroll
      for (int u = 0; u < 2; u++) {
        const int t = tb + u * stride2;
        if (t < NT) {
          const u16* pr = P0b + (long)t * 1280;
#pragma unroll
          for (int j = 0; j < 19; j++) raw[u][j] = pr[j * 64 + lane];
        }
      }
#pragma unroll
      for (int u = 0; u < 2; u++) {
        const int t = tb + u * stride2;
        if (t < NT) {
          const int pos = tok_pos(t);
          const long kv = tok_kv(t);
          float* lat_o = (t < NP) ? p.out + O_LATP + (long)t * 256 : p.out + O_LATS + (long)(t - NP) * 256;
          float* kr_o = (t < NP) ? p.out + O_KRP + (long)t * 64 : p.out + O_KRS + (long)(t - NP) * 64;
          float cq[6]; float ss = 0.f;
#pragma unroll
          for (int j = 0; j < 6; j++) { cq[j] = bf2f(raw[u][j]); ss += cq[j] * cq[j]; }
          ss = wave_sum(ss);
          float r = rsqrtf(ss * (1.f / 384.f) + EPS);
#pragma unroll
          for (int j = 0; j < 6; j++) cqn[(long)t * 384 + j * 64 + lane] = f2bf(cq[j] * r);
          float ck[4]; ss = 0.f;
#pragma unroll
          for (int j = 0; j < 4; j++) { ck[j] = bf2f(raw[u][6 + j]); ss += ck[j] * ck[j]; }
          ss = wave_sum(ss);
          r = rsqrtf(ss * (1.f / 256.f) + EPS);
#pragma unroll
          for (int j = 0; j < 4; j++) {
            const float v = ck[j] * r * gkv[j * 64 + lane];
            lat_o[j * 64 + lane] = v;
            latall[kv * 256 + j * 64 + lane] = f2bf(v);
          }
          {
            const float xv = bf2f(raw[u][10]);
            const float pv = __shfl_xor(xv, 32);
            const int i = lane & 31;
            const float c = ct[pos * 32 + i], s = st[pos * 32 + i];
            const float v = (lane < 32) ? xv * c - pv * s : xv * c + pv * s;
            kr_o[lane] = v;
            krall[kv * 64 + lane] = f2bf(v);
          }
#pragma unroll
          for (int j = 0; j < 8; j++) xq[(long)t * 512 + j * 64 + lane] = f2bf(bf2f(raw[u][11 + j]) * XSCALE);
        }
      }
    }
  }
  GRID_BARRIER();

  for (int g = 0; g < 2; g++) {
    {
      const u16* cqn = (const u16*)(launder(p.ws) + W_CQN);
      const u16* wuqT = (const u16*)(launder(p.ws) + W_UQT);
      const u16* latall = (const u16*)(launder(p.ws) + W_LATALL);
      const u16* lats = latall + (long)NP * 256;
      const u16* wukT = (const u16*)(launder(p.ws) + W_UKT);
      const u16* wuvT = (const u16*)(launder(p.ws) + W_UVT);
      const u16* wukTg = wukT + (long)g * 512 * 256;
      const u16* wuvTg = wuvT + (long)g * 512 * 256;
      const float* ct = (const float*)(launder(p.ws) + W_ROPE);
      const float* st = ct + 16384 * 32;
      u16* Q = (u16*)(launder(p.ws) + W_Q);
      u16* knp = (u16*)(launder(p.ws) + W_KNP);
      u16* vtp = (u16*)(launder(p.ws) + W_VTP);
      u16* kns = (u16*)(launder(p.ws) + W_KNS);
      u16* vts = (u16*)(launder(p.ws) + W_VTS);
      const int n_q = (g == 0) ? (NT / 128) * 12 : 0;
      const int n_kp = (g == 0) ? (NP / 128) * 8 : 0, n_vp = n_kp;
      const int n_ks = (NSKV / 128) * 4, n_vs = n_ks;
      const int e1 = n_q, e2 = e1 + n_kp, e3 = e2 + n_vp, e4 = e3 + n_ks, e5 = e4 + n_vs;
      for (int t = blockIdx.x; t < e5; t += gridDim.x) {
        f32x16 acc[2][2];
        if (t < e1) {
          const int tm = t % (NT / 128), tn = t / (NT / 128), m0 = tm * 128, n0 = tn * 128;
          gemm_core([=](int m, int k) { return cqn + (long)m * 384 + k; },
                    [=](int n, int k) { return wuqT + (long)n * 384 + k; }, m0, n0, 384, smem, acc);
          const int tid = opaque_tid(), lane = tid & 63, wv = tid >> 6;
          const int wm = wv >> 1, wn = wv & 1, h = lane >> 5, r = lane & 31;
          const int nw0 = n0 + wn * 64;
          const bool is_rope = (nw0 % 192) == 128;
          if (is_rope) {
#pragma unroll
            for (int mt = 0; mt < 2; mt++)
#pragma unroll
              for (int i = 0; i < 16; i++) {
                const int m = m0 + wm * 64 + mt * 32 + crow(i, h);
                const float v0 = acc[mt][0][i], v1 = acc[mt][1][i];
                const int pos = tok_pos(m);
                const float c = ct[pos * 32 + r], s = st[pos * 32 + r];
                Q[(long)m * 1536 + nw0 + r] = f2bf((v0 * c - v1 * s) * QSCALE);
                Q[(long)m * 1536 + nw0 + 32 + r] = f2bf((v1 * c + v0 * s) * QSCALE);
              }
          } else {
#pragma unroll
            for (int mt = 0; mt < 2; mt++)
#pragma unroll
              for (int i = 0; i < 16; i++) {
                const int m = m0 + wm * 64 + mt * 32 + crow(i, h);
                Q[(long)m * 1536 + nw0 + r] = f2bf(acc[mt][0][i] * QSCALE);
                Q[(long)m * 1536 + nw0 + 32 + r] = f2bf(acc[mt][1][i] * QSCALE);
              }
          }
        } else if (t < e2) {
          const int tt = t - e1, tm = tt % (NP / 128), tn = tt / (NP / 128);
          gemm_core([=](int m, int k) { return latall + (long)m * 256 + k; },
                    [=](int n, int k) { return wukT + (long)n * 256 + k; }, tm * 128, tn * 128, 256, smem, acc);
          epi_bf16_tile(acc, tm * 128, tn * 128, knp + ((long)tn * NP + tm * 128) * 128, 128, smem, [=](int m, int n, float v) { return v; });
        } else if (t < e3) {
          const int tt = t - e2, tn = tt % (NP / 128), tm = tt / (NP / 128);
          gemm_core([=](int m, int k) { return wuvT + (long)m * 256 + k; },
                    [=](int n, int k) { return latall + (long)n * 256 + k; }, tm * 128, tn * 128, 256, smem, acc);
          epi_bf16_vtile(acc, vtp + ((long)tm * (NP / 64) + 2 * tn) * 8192, smem, [=](float v) { return v; });
        } else if (t < e4) {
          const int tt = t - e3, tm = tt % (NSKV / 128), tn = tt / (NSKV / 128);
          gemm_core([=](int m, int k) { return lats + (long)m * 256 + k; },
                    [=](int n, int k) { return wukTg + (long)n * 256 + k; }, tm * 128, tn * 128, 256, smem, acc);
          epi_bf16_tile(acc, tm * 128, tn * 128, kns + ((long)tn * NSKV + tm * 128) * 128, 128, smem, [=](int m, int n, float v) { return v; });
        } else {
          const int tt = t - e4, tn = tt % (NSKV / 128), tm = tt / (NSKV / 128);
          gemm_core([=](int m, int k) { return wuvTg + (long)m * 256 + k; },
                    [=](int n, int k) { return lats + (long)n * 256 + k; }, tm * 128, tn * 128, 256, smem, acc);
          epi_bf16_vtile(acc, vts + ((long)tm * (NSKV / 64) + 2 * tn) * 8192, smem, [=](float v) { return v; });
        }
      }
    }
    GRID_BARRIER();
    attn_phase_l0(p, g, qcnt + g, smem);
    GRID_BARRIER();
  }

  {
    const u16* Q = (const u16*)(launder(p.ws) + W_Q);
    const u16* xq = (const u16*)(launder(p.ws) + W_XQ0);
    const u16* woutT = (const u16*)(launder(p.ws) + W_OUT0T);
    u16* Y = (u16*)(launder(p.ws) + W_Y7);
    gemm_phase_n1024(1536,
               [=](int m, int k) { return (k < 1024) ? Q + (long)m * 1536 + (k >> 7) * 192 + (k & 127) : xq + (long)m * 512 + (k - 1024); },
               [=](int n, int k) { return woutT + (long)n * 1536 + k; }, Y, (u16*)(launder(p.ws) + W_PART7), smem);
  }
  GRID_BARRIER();
  rowwise_residual(p, (const u16*)(launder(p.ws) + W_Y7), p.in[I_LMPOST], 0, (const u16*)(launder(p.ws) + W_PART7));
  convert_weight(p.in[I_WUP], 1024, 4096, 4096, p.in[I_LFPRE], (u16*)(launder(p.ws) + W_UP0T), smem);
  convert_weight(p.in[I_WDOWN], 4096, 1024, 1024, nullptr, (u16*)(launder(p.ws) + W_DOWN0T), smem);
  GRID_BARRIER();
  ffn_up_phase(p, xres_base(p), XR_LD, (const u16*)(launder(p.ws) + W_UP0T), (u16*)(launder(p.ws) + W_HID0), smem);
  GRID_BARRIER();
  ffn_down_phase((const u16*)(launder(p.ws) + W_HID0), (const u16*)(launder(p.ws) + W_DOWN0T), (u16*)(launder(p.ws) + W_Y10), (u16*)(launder(p.ws) + W_PART10), smem);
  GRID_BARRIER();
  rowwise_residual(p, (const u16*)(launder(p.ws) + W_Y10), p.in[I_LFPOST], 1, (const u16*)(launder(p.ws) + W_PART10));
  convert_weight(p.in[I_WIN1], 1024, 4608, 4608, p.in[I_LMPRE] + 1024, (u16*)(launder(p.ws) + W_IN1T), smem);
  convert_weight(p.in[I_WOUT1], 1536, 1024, 1024, nullptr, (u16*)(launder(p.ws) + W_OUT1T), smem, 128);
  GRID_BARRIER();
  {
    const u16* xb1 = xres_base(p);
    const u16* win1T = (const u16*)(launder(p.ws) + W_IN1T);
    u16* qs = (u16*)(launder(p.ws) + W_QS);
    float* f = (float*)(launder(p.ws) + W_F);
    u16* vv = (u16*)(launder(p.ws) + W_V);
    u16* gs = (u16*)(launder(p.ws) + W_GS);
    u16* xq1 = (u16*)(launder(p.ws) + W_XQ1);
    const float* rs = (const float*)(launder(p.ws) + W_RS);
    gemm_phase(NT / 128, 36, 1024,
               [=](int m, int k) { return xb1 + (long)m * XR_LD + k; },
               [=](int n, int k) { return win1T + (long)n * 1024 + k; },
               [=](const f32x16 (&acc)[2][2], int m0, int n0) {
                 const int cb = n0 >> 10;
                 if (cb == 0) epi_bf16_tile(acc, m0, n0, qs + (long)m0 * 1024 + n0, 1024, smem, [=](int m, int n, float v) { return siluf_(v * rs[m]); });
                 else if (cb == 1) epi_each(acc, m0, n0, [=](int m, int n, float v) { f[(long)m * 1024 + (n - 1024)] = v * rs[m]; });
                 else if (cb == 2) epi_bf16_tile(acc, m0, n0, vv + (long)m0 * 1024 + (n0 - 2048), 1024, smem, [=](int m, int n, float v) { return v * rs[m]; });
                 else if (cb == 3) epi_bf16_tile(acc, m0, n0, gs + (long)m0 * 1024 + (n0 - 3072), 1024, smem, [=](int m, int n, float v) { return siluf_(v * rs[m]); });
                 else epi_bf16_tile(acc, m0, n0, xq1 + (long)m0 * 512 + (n0 - 4096), 512, smem, [=](int m, int n, float v) { return v * rs[m] * XSCALE; });
               }, smem);
  }
  GRID_BARRIER();
  for (int it = blockIdx.x; it < NCHUNK * 8; it += gridDim.x) hgrn_chunk_item(p, it >> 3, it & 7, smem);
  GRID_BARRIER();
  hgrn_scan_phase(p, smem);
  __syncthreads();
  convert_mem_cache(p, 1, (u16*)(launder(p.ws) + W_MEMKS1), (u16*)(launder(p.ws) + W_MEMVTS1), smem);
  GRID_BARRIER();
  for (int it = blockIdx.x; it < NCHUNK * 8; it += gridDim.x) hgrn_final_item(p, it >> 3, it & 7, smem);
  cross_phase_l1(p, qcnt + 2, smem);
  GRID_BARRIER();
  {
    const u16* mix = (const u16*)(launder(p.ws) + W_QS);
    const u16* xq1 = (const u16*)(launder(p.ws) + W_XQ1);
    const u16* woutT = (const u16*)(launder(p.ws) + W_OUT1T);
    u16* Y = (u16*)(launder(p.ws) + W_Y16);
    gemm_phase_n1024(1536,
               [=](int m, int k) { return (k < 1024) ? mix + (long)m * 1024 + k : xq1 + (long)m * 512 + (k - 1024); },
               [=](int n, int k) { return woutT + (long)n * 1536 + k; }, Y, (u16*)(launder(p.ws) + W_PART16), smem);
  }
  GRID_BARRIER();
  rowwise_residual(p, (const u16*)(launder(p.ws) + W_Y16), p.in[I_LMPOST] + 1024, 1, (const u16*)(launder(p.ws) + W_PART16));
  convert_weight(p.in[I_WUP] + 1024L * 4096, 1024, 4096, 4096, p.in[I_LFPRE] + 1024, (u16*)(launder(p.ws) + W_UP1T), smem);
  convert_weight(p.in[I_WDOWN] + 4096L * 1024, 4096, 1024, 1024, nullptr, (u16*)(launder(p.ws) + W_DOWN1T), smem);
  GRID_BARRIER();
  ffn_up_phase(p, xres_base(p), XR_LD, (const u16*)(launder(p.ws) + W_UP1T), (u16*)(launder(p.ws) + W_HID1), smem);
  GRID_BARRIER();
  ffn_down_phase((const u16*)(launder(p.ws) + W_HID1), (const u16*)(launder(p.ws) + W_DOWN1T), (u16*)(launder(p.ws) + W_Y19), (u16*)(launder(p.ws) + W_PART19), smem);
  GRID_BARRIER();
  rowwise_residual(p, (const u16*)(launder(p.ws) + W_Y19), p.in[I_LFPOST] + 1024, 2, (const u16*)(launder(p.ws) + W_PART19));
}

extern "C" void kernel_launch(void* const* d_in, const int* in_sizes, int n_in, void* d_out, int out_size,
                              void* d_ws, size_t ws_size, hipStream_t stream) {
  static int grid_blocks = 0;
  if (!grid_blocks) {
    int dev = 0, cus = 0, per_cu = 0;
    (void)hipGetDevice(&dev);
    (void)hipDeviceGetAttribute(&cus, hipDeviceAttributeMultiprocessorCount, dev);
    (void)hipOccupancyMaxActiveBlocksPerMultiprocessor(&per_cu, fwd_megakernel, 256, 0);
    if (per_cu > 2) per_cu = 2;
    if (per_cu < 1) per_cu = 1;
    grid_blocks = cus * per_cu;
  }
  if (ws_size < WS_NEED || n_in < 27) { fprintf(stderr, "workspace too small: %zu < %zu\n", ws_size, WS_NEED); return; }
  Params p;
  memset(&p, 0, sizeof(p));
  for (int i = 0; i < 27; i++) p.in[i] = (const float*)d_in[i];
  p.out = (float*)d_out;
  p.ws = (char*)d_ws;
  for (int i = 0; i < 32; i++) p.inv_freq[i] = pow(10000.0, -(double)i / 32.0);
  p.never = 0;
  (void)hipMemsetAsync(d_ws, 0, 65536, stream);
  void* args[] = {&p};
  hipError_t e = hipLaunchCooperativeKernel((void*)fwd_megakernel, dim3(grid_blocks), dim3(256), args, 0, stream);
  if (e != hipSuccess) fprintf(stderr, "cooperative launch failed: %s (grid %d)\n", hipGetErrorString(e), grid_blocks);
}
```
